# Optimizing an MI355X kernel written in HIP

```python
import math
import jax
import jax.numpy as jnp
from jax import lax
import numpy as np

D_MODEL = 1024
BATCH = 8
SEQ = 4096
DEPTH = 1

D_MIX = D_MODEL
CONV_WIDTH = D_MIX // 2
SG_WIDTH = D_MIX - CONV_WIDTH
N_CONV_HEADS = 8
N_SG_HEADS = 8
CONV_HEAD_DIM = CONV_WIDTH // N_CONV_HEADS
SG_HEAD_DIM = SG_WIDTH // N_SG_HEADS
CONV_KERNEL = 31
SG_CHUNK = 128
PEER_HEADS = 8
PEER_TOPK = 16
N_KEYS = 128
N_EXPERTS = N_KEYS * N_KEYS
D_KEY = 256
D_HALF = D_KEY // 2
PEER_TOKEN_BLOCK = 128
PLE_DIM = 256
ALPHA = (2.0 * DEPTH) ** 0.25
BETA = (8.0 * DEPTH) ** -0.25
LN_EPS = 1e-5
D_IN = 2 * CONV_WIDTH + 2 * SG_WIDTH

kernel_name = "hymba_conformer_sgu_peer_deepnorm"


def layer_norm(x, g, b):
    xf = x.astype(jnp.float32)
    mu = jnp.mean(xf, axis=-1, keepdims=True)
    var = jnp.mean(jnp.square(xf - mu), axis=-1, keepdims=True)
    return ((xf - mu) * lax.rsqrt(var + LN_EPS)).astype(x.dtype) * g + b


def group_norm(x, g, b, groups):
    c = x.shape[-1]
    xs = x.reshape(*x.shape[:-1], groups, c // groups)
    y = layer_norm(xs, g.reshape(groups, c // groups), b.reshape(groups, c // groups))
    return y.reshape(x.shape)


def conformer_conv(a, gate, conv_w, conv_b, gn_g, gn_b):
    c = a * jax.nn.sigmoid(gate)
    rhs = conv_w[:, None, :].astype(c.dtype)
    y = lax.conv_general_dilated(
        c, rhs, window_strides=(1,), padding=[(CONV_KERNEL - 1, 0)],
        dimension_numbers=("NWC", "WIO", "NWC"),
        feature_group_count=CONV_WIDTH) + conv_b
    y = group_norm(y, gn_g, gn_b, N_CONV_HEADS)
    return jax.nn.silu(y)


def spatial_gating(u, v, ln_g, ln_b, sg_w, sg_b):
    bsz, s, _ = u.shape
    u = jax.nn.gelu(u, approximate=False)
    v = group_norm(jax.nn.gelu(v, approximate=False), ln_g, ln_b, N_SG_HEADS)
    nc = s // SG_CHUNK
    vc = v.reshape(bsz, nc, SG_CHUNK, N_SG_HEADS, SG_HEAD_DIM)
    uc = u.reshape(bsz, nc, SG_CHUNK, N_SG_HEADS, SG_HEAD_DIM)
    mask = jnp.tril(jnp.ones((SG_CHUNK, SG_CHUNK), dtype=sg_w.dtype))
    wm = sg_w * mask[None]
    f = jnp.einsum("hts,bcshd->bcthd", wm, vc) + sg_b.T[None, None, :, :, None]
    return (uc * f).reshape(bsz, s, SG_WIDTH)


def peer(h, wq, keys, u_tab, v_tab):
    bsz, s, d = h.shape
    xt = h.reshape(bsz * s // PEER_TOKEN_BLOCK, PEER_TOKEN_BLOCK, d)

    def block(xc):
        c = xc.shape[0]
        q = (xc @ wq).reshape(c, PEER_HEADS, 2, D_HALF)
        s1 = jnp.einsum("chd,hkd->chk", q[:, :, 0], keys[:, 0])
        s2 = jnp.einsum("chd,hkd->chk", q[:, :, 1], keys[:, 1])
        v1, i1 = lax.top_k(s1, PEER_TOPK)
        v2, i2 = lax.top_k(s2, PEER_TOPK)
        comb = (v1[..., :, None] + v2[..., None, :]).reshape(c, PEER_HEADS, PEER_TOPK * PEER_TOPK)
        sc, pos = lax.top_k(comb, PEER_TOPK)
        a_sel = jnp.take_along_axis(i1, pos // PEER_TOPK, axis=-1)
        b_sel = jnp.take_along_axis(i2, pos % PEER_TOPK, axis=-1)
        idx = a_sel * N_KEYS + b_sel
        g = jax.nn.softmax(sc.astype(jnp.float32), axis=-1).astype(xc.dtype)
        ug = jnp.take(u_tab, idx, axis=0)
        act = jax.nn.gelu(jnp.einsum("cd,chkd->chk", xc, ug), approximate=False)
        vg = jnp.take(v_tab, idx, axis=0)
        return jnp.einsum("chk,chkd->cd", g * act, vg)

    y = lax.map(block, xt)
    return y.reshape(bsz, s, d)


def setup_inputs(seed: int = 0) -> dict:
    key = jax.random.key(seed)
    ks = jax.random.split(key, 32)
    L = DEPTH
    f32 = jnp.float32

    def nrm(k, shape, scale):
        return jax.random.normal(k, shape, f32) * scale

    return {
        "x": nrm(ks[0], (BATCH, SEQ, D_MODEL), 1.0),
        "p": nrm(ks[1], (DEPTH, BATCH, SEQ, PLE_DIM), 1.0),
        "ln0_g": 1.0 + nrm(ks[2], (D_MODEL,), 0.02),
        "ln0_b": nrm(ks[3], (D_MODEL,), 0.02),
        "w_in": nrm(ks[4], (L, D_MODEL, D_IN), D_MODEL ** -0.5),
        "b_in": nrm(ks[5], (L, D_IN), 0.02),
        "conv_w": nrm(ks[6], (L, CONV_KERNEL, CONV_WIDTH), CONV_KERNEL ** -0.5),
        "conv_b": nrm(ks[7], (L, CONV_WIDTH), 0.02),
        "gn_g": 1.0 + nrm(ks[8], (L, CONV_WIDTH), 0.02),
        "gn_b": nrm(ks[9], (L, CONV_WIDTH), 0.02),
        "sg_ln_g": 1.0 + nrm(ks[10], (L, SG_WIDTH), 0.02),
        "sg_ln_b": nrm(ks[11], (L, SG_WIDTH), 0.02),
        "sg_w": nrm(ks[12], (L, N_SG_HEADS, SG_CHUNK, SG_CHUNK), SG_CHUNK ** -0.5),
        "sg_b": 1.0 + nrm(ks[13], (L, N_SG_HEADS, SG_CHUNK), 0.02),
        "w_o": nrm(ks[14], (L, D_MIX, D_MODEL), BETA * D_MIX ** -0.5),
        "b_o": nrm(ks[15], (L, D_MODEL), 0.02),
        "ln1_g": 1.0 + nrm(ks[16], (L, D_MODEL), 0.02),
        "ln1_b": nrm(ks[17], (L, D_MODEL), 0.02),
        "peer_wq": nrm(ks[18], (L, D_MODEL, PEER_HEADS * D_KEY), D_MODEL ** -0.5),
        "peer_keys": nrm(ks[19], (L, PEER_HEADS, 2, N_KEYS, D_HALF), D_HALF ** -0.5),
        "peer_u": nrm(ks[20], (L, N_EXPERTS, D_MODEL), D_MODEL ** -0.5),
        "peer_v": nrm(ks[21], (L, N_EXPERTS, D_MODEL), BETA * 0.5),
        "ple_wp": nrm(ks[22], (L, PLE_DIM, D_MODEL), BETA * PLE_DIM ** -0.5),
        "ple_wg": nrm(ks[23], (L, D_MODEL, D_MODEL), D_MODEL ** -0.5),
        "ple_bg": nrm(ks[24], (L, D_MODEL), 0.02),
        "ln2_g": 1.0 + nrm(ks[25], (L, D_MODEL), 0.02),
        "ln2_b": nrm(ks[26], (L, D_MODEL), 0.02),
    }


def reference(x, p, ln0_g, ln0_b, w_in, b_in, conv_w, conv_b, gn_g, gn_b,
              sg_ln_g, sg_ln_b, sg_w, sg_b, w_o, b_o, ln1_g, ln1_b,
              peer_wq, peer_keys, peer_u, peer_v, ple_wp, ple_wg, ple_bg,
              ln2_g, ln2_b):
    h = layer_norm(x, ln0_g, ln0_b)
    for i in range(DEPTH):
        z = h @ w_in[i] + b_in[i]
        ca, cg, su, sv = jnp.split(
            z, [CONV_WIDTH, 2 * CONV_WIDTH, 2 * CONV_WIDTH + SG_WIDTH], axis=-1)
        conv_out = conformer_conv(ca, cg, conv_w[i], conv_b[i], gn_g[i], gn_b[i])
        sg_out = spatial_gating(su, sv, sg_ln_g[i], sg_ln_b[i], sg_w[i], sg_b[i])
        mix = jnp.concatenate([conv_out, sg_out], axis=-1) @ w_o[i] + b_o[i]
        h = layer_norm(ALPHA * h + mix, ln1_g[i], ln1_b[i])
        ff = peer(h, peer_wq[i], peer_keys[i], peer_u[i], peer_v[i])
        ple = jax.nn.sigmoid(h @ ple_wg[i] + ple_bg[i]) * (p[i] @ ple_wp[i])
        h = layer_norm(ALPHA * h + ff + ple, ln2_g[i], ln2_b[i])
    return h
```

```cpp
#include <hip/hip_runtime.h>
#include <cstdio>
#include <cstdint>
namespace pg8 {
#define PG8_LAS __attribute__((address_space(3)))
typedef unsigned short bf16_t;
typedef short bf16x8 __attribute__((ext_vector_type(8)));
typedef float f32x4 __attribute__((ext_vector_type(4)));
typedef unsigned u32x4 __attribute__((ext_vector_type(4)));
constexpr int BM = 256, BK = 64, HALF = 128, HTB = HALF * BK * 2  , STAGE_BYTES = 8 * HTB, NXCD = 8, WGM = 8;

__host__ __device__ __forceinline__ int lds_byte(int r, int c) { const int st = (r >> 4) * 2 + (c >> 5), rr = r & 15, cc = c & 31, ob = rr * 64 + cc * 2; return st * 1024 + (ob ^ (((ob >> 9) & 1) << 5)); }
__host__ __device__ __forceinline__ void stage_rc(int b, int& R, int& C) { const int st = b / 1024, sb = b % 1024, swz = sb ^ (((sb >> 9) & 1) << 5); R = (st >> 1) * 16 + swz / 64; C = (st & 1) * 32 + (swz % 64) / 2; }
__host__ __device__ __forceinline__ int perm32(int rho) { const int n = rho >> 4, i = rho & 15; return 8 * (i >> 2) + 4 * n + (i & 3); }

struct Unit { int pm, pn; };
struct Gemm { const bf16_t* A; const bf16_t* Bt; int M, N, K; };

struct StaticOrder {
    int nM, nN, nwg, G, c;
    __host__ __device__ void init(int M, int N, int G_, int c_) { nM = M / BM; nN = N / BM; nwg = nM * nN; G = G_; c = c_; }
    __host__ __device__ bool next(int i, Unit& u) const {
        const long L = (long)i * G + c; if (L >= nwg) return false;
        int wgid = (int)L; { const int q = nwg / NXCD, r = nwg % NXCD, xcd = wgid % NXCD, off = wgid / NXCD; wgid = (xcd < r ? xcd * (q + 1) : r * (q + 1) + (xcd - r) * q) + off; }
        const int nig = WGM * nN, gid = wgid / nig, fm = gid * WGM, gsz = (nM - fm) < WGM ? (nM - fm) : WGM;
        u.pm = fm + ((wgid % nig) % gsz); u.pn = (wgid % nig) / gsz; return true;
    }
    __device__ __forceinline__ void a_ready(const Unit&) const {}
    __device__ __forceinline__ void done(const Unit&) const {}
};

__device__ __forceinline__ unsigned cvt_pk_bf16(float lo, float hi) { unsigned r; asm volatile("v_cvt_pk_bf16_f32 %0, %1, %2" : "=v"(r) : "v"(lo), "v"(hi)); return r; }
typedef float f32x2 __attribute__((ext_vector_type(2)));
__device__ __forceinline__ f32x2 gelu_pk(f32x2 v) {
    const f32x2 av = __builtin_elementwise_abs(v), d = av * 0.2316418882f + 1.0f;
    f32x2 t; t.x = __builtin_amdgcn_rcpf(d.x); t.y = __builtin_amdgcn_rcpf(d.y);
    f32x2 q = t * 0.5307027145f + (-0.7265760135f); q = q * t + 0.7107068705f; q = q * t + (-0.142248368f); q = q * t + 0.127414796f; q = q * t;
    const f32x2 s = (v * v) * (-0.72134752044f);
    f32x2 e; e.x = __builtin_amdgcn_exp2f(s.x); e.y = __builtin_amdgcn_exp2f(s.y);
    const f32x2 m = v * (q * e), r = v - m;
    f32x2 o; o.x = v.x < 0.f ? m.x : r.x; o.y = v.y < 0.f ? m.y : r.y; return o;
}

template <int ACT  > struct EpiBf16 {
    static constexpr bool PERM = true, AFTER_DRAIN = false; static_assert(ACT == 0 || ACT == 1, "EpiBf16: ACT is 0 (none) or 1 (gelu_pk)");
    bf16_t* O; int ldc; const float* bias; int split_cols; size_t split_stride; float scale0;
    __device__ __forceinline__ void operator()(const f32x4 (&acc)[2][2][4][2], const Unit& u, int wr, int wc, int fr, int fq) const {
        const int row0 = u.pm * BM + wr * 64 + fr; int colt = u.pn * BM; bf16_t* base = O;
        float sc = 1.f; if (split_cols) { const int t = colt / split_cols; base += (size_t)t * split_stride; colt -= t * split_cols; if (t == 0) sc = scale0; }
        const int col0 = colt + wc * 32 + 8 * fq, bcol0 = u.pn * BM + wc * 32 + 8 * fq;
        f32x4 bv[2][2];
#pragma unroll
        for (int bj = 0; bj < 2; ++bj)
#pragma unroll
            for (int n = 0; n < 2; ++n) bv[bj][n] = bias ? *(const f32x4*)(bias + bcol0 + bj * HALF + 4 * n) : (f32x4){0.f, 0.f, 0.f, 0.f};
#pragma unroll
        for (int ai = 0; ai < 2; ++ai)
#pragma unroll
            for (int m = 0; m < 4; ++m) { bf16_t* rowp = base + (size_t)(row0 + ai * HALF + m * 16) * ldc + col0;
#pragma unroll
                for (int bj = 0; bj < 2; ++bj) { f32x4 v0 = acc[ai][bj][m][0] + bv[bj][0], v1 = acc[ai][bj][m][1] + bv[bj][1];
                    if (ACT == 1) { f32x2 a = gelu_pk((f32x2){v0[0], v0[1]}), b = gelu_pk((f32x2){v0[2], v0[3]}), c = gelu_pk((f32x2){v1[0], v1[1]}), d = gelu_pk((f32x2){v1[2], v1[3]});
                        v0 = (f32x4){a.x, a.y, b.x, b.y}; v1 = (f32x4){c.x, c.y, d.x, d.y}; }
                    v0 = v0 * sc; v1 = v1 * sc; u32x4 w; w.x = cvt_pk_bf16(v0[0], v0[1]); w.y = cvt_pk_bf16(v0[2], v0[3]); w.z = cvt_pk_bf16(v1[0], v1[1]); w.w = cvt_pk_bf16(v1[2], v1[3]);
                    *(u32x4*)(rowp + bj * HALF) = w; } }
    }
};

template <class Epi, class Sched, bool ALIGN_EPI = false, bool SP2 = false>
__device__ __forceinline__ void gemm_phase(PG8_LAS unsigned char* lds, const Gemm g, const Sched& S, const Epi& E) {
    const int tid = threadIdx.x, wid = __builtin_amdgcn_readfirstlane(tid >> 6), lane = tid & 63, wr = wid >> 2, wc = wid & 3, fr = lane & 15, fq = lane >> 4;
    const int K = g.K, nt = K / BK;
    unsigned voffA[2], voffB[2];
#pragma unroll
    for (int i = 0; i < 2; ++i) { int R, C; stage_rc(tid * 16 + i * 8192, R, C); const int Rb = Epi::PERM ? ((R & ~31) + perm32(R & 31)) : R;
        voffA[i] = (unsigned)(R * K + C) * 2u; voffB[i] = (unsigned)(Rb * K + C) * 2u; }
    const size_t kstep = (size_t)(BK * 2);
    const size_t hstep = (size_t)HALF * K * 2;
    const size_t tstep = 2 * hstep;
    const unsigned ldsw = (unsigned)wid * 1024u;
    const int aoff = lds_byte(wr * 64 + fr, fq * 8), boff = lds_byte(wc * 32 + fr, fq * 8);
#define PG8_SA(b, h) (((b) * 2 + (h)) * HTB)
#define PG8_SB(b, h) ((4 + (b) * 2 + (h)) * HTB)
#define PG8_STAGE(bufoff, gbase, voff) do { _Pragma("unroll") for (int _i = 0; _i < 2; ++_i) \
        __builtin_amdgcn_global_load_lds((const unsigned*)((const char*)(gbase) + (voff)[_i]), (PG8_LAS unsigned*)(lds + (bufoff) + ldsw + _i * 8192), 16, 0, 0); } while (0)
#define PG8_LDA(dst, b, h) do { _Pragma("unroll") for (int m = 0; m < 4; ++m) _Pragma("unroll") for (int k = 0; k < 2; ++k) dst[m][k] = *(const PG8_LAS bf16x8*)(lds + PG8_SA(b, h) + aoff + m * 2048 + k * 1024); } while (0)
#define PG8_LDB(dst, b, h) do { _Pragma("unroll") for (int n = 0; n < 2; ++n) _Pragma("unroll") for (int k = 0; k < 2; ++k) dst[n][k] = *(const PG8_LAS bf16x8*)(lds + PG8_SB(b, h) + boff + n * 2048 + k * 1024); } while (0)
#define PG8_MMA(ai, bj, At, Bt) do { __builtin_amdgcn_s_setprio(1); _Pragma("unroll") for (int m = 0; m < 4; ++m) _Pragma("unroll") for (int n = 0; n < 2; ++n) _Pragma("unroll") for (int k = 0; k < 2; ++k) \
        acc[ai][bj][m][n] = __builtin_amdgcn_mfma_f32_16x16x32_bf16(Bt[n][k], At[m][k], acc[ai][bj][m][n], 0, 0, 0); __builtin_amdgcn_s_setprio(0); } while (0)
#define PG8_WAIT_V(n) asm volatile("s_waitcnt vmcnt(" #n ")" ::: "memory")
#define PG8_WAIT_L(n) asm volatile("s_waitcnt lgkmcnt(" #n ")" ::: "memory")
#define PG8_BAR __builtin_amdgcn_s_barrier()
#define PG8_SCHED __builtin_amdgcn_sched_barrier(0)
    Unit cur, nxt; int ui = 0;
    if (!S.next(0, cur)) return;
    f32x4 acc[2][2][4][2];
#pragma unroll
    for (int a = 0; a < 2; ++a)
#pragma unroll
        for (int b = 0; b < 2; ++b)
#pragma unroll
            for (int m = 0; m < 4; ++m)
#pragma unroll
                for (int n = 0; n < 2; ++n) acc[a][b][m][n] = (f32x4){0.f, 0.f, 0.f, 0.f};
    bf16x8 At[4][2], B0[2][2], B1[2][2];
    const char* cA = (const char*)g.A + (size_t)cur.pm * tstep; const char* cB = (const char*)g.Bt + (size_t)cur.pn * tstep;
    S.a_ready(cur);
    if constexpr (SP2) {
        PG8_STAGE(PG8_SB(0, 0), cB, voffB); PG8_STAGE(PG8_SB(0, 1), cB + hstep, voffB); PG8_STAGE(PG8_SA(0, 0), cA, voffA); PG8_STAGE(PG8_SA(0, 1), cA + hstep, voffA);
        if (wr == 1) PG8_BAR;
        PG8_WAIT_V(2); PG8_BAR;
        PG8_STAGE(PG8_SB(1, 0), cB + kstep, voffB); PG8_STAGE(PG8_SA(1, 0), cA + kstep, voffA); PG8_STAGE(PG8_SB(1, 1), cB + hstep + kstep, voffB);
        PG8_WAIT_V(6); PG8_BAR;
    } else {
        PG8_STAGE(PG8_SB(0, 0), cB, voffB); PG8_STAGE(PG8_SA(0, 0), cA, voffA); PG8_STAGE(PG8_SB(0, 1), cB + hstep, voffB); PG8_STAGE(PG8_SA(0, 1), cA + hstep, voffA);
        if (wr == 1) PG8_BAR;
        PG8_WAIT_V(4); PG8_BAR;
        PG8_STAGE(PG8_SB(1, 0), cB + kstep, voffB); PG8_STAGE(PG8_SA(1, 0), cA + kstep, voffA); PG8_STAGE(PG8_SB(1, 1), cB + hstep + kstep, voffB);
        PG8_WAIT_V(6); PG8_BAR;
    }
    for (;;) {
        const bool has_next = S.next(ui + 1, nxt);
        const char* nA = has_next ? (const char*)g.A + (size_t)nxt.pm * tstep : cA; const char* nB = has_next ? (const char*)g.Bt + (size_t)nxt.pn * tstep : cB;
        for (int t = 0; t < nt; t += 2) {
            const bool last = (t == nt - 2);
            const char* a1 = cA + (size_t)(t + 1) * kstep;
            const char* a2 = last ? nA : cA + (size_t)(t + 2) * kstep; const char* b2 = last ? nB : cB + (size_t)(t + 2) * kstep;
            const char* a3 = a2 + kstep; const char* b3 = b2 + kstep;
            if (last && has_next) S.a_ready(nxt);
            if constexpr (SP2) {
            PG8_LDB(B0, 0, 0); PG8_LDB(B1, 0, 1); PG8_SCHED; PG8_LDA(At, 0, 0); PG8_STAGE(PG8_SA(1, 1), a1 + hstep, voffA);
            PG8_WAIT_V(8); PG8_WAIT_L(0); PG8_BAR; PG8_MMA(0, 0, At, B0); PG8_MMA(0, 1, At, B1); PG8_BAR; PG8_SCHED;
            PG8_LDA(At, 0, 1); PG8_STAGE(PG8_SB(0, 0), b2, voffB); PG8_STAGE(PG8_SB(0, 1), b2 + hstep, voffB); PG8_STAGE(PG8_SA(0, 0), a2, voffA);
            PG8_WAIT_V(8); PG8_WAIT_L(0); PG8_BAR; PG8_MMA(1, 0, At, B0); PG8_MMA(1, 1, At, B1); PG8_BAR; PG8_SCHED;
            PG8_LDB(B0, 1, 0); PG8_LDB(B1, 1, 1); PG8_SCHED; PG8_LDA(At, 1, 0); PG8_STAGE(PG8_SA(0, 1), a2 + hstep, voffA);
            PG8_WAIT_V(8); PG8_WAIT_L(0); PG8_BAR; PG8_MMA(0, 0, At, B0); PG8_MMA(0, 1, At, B1); PG8_BAR; PG8_SCHED;
            PG8_LDA(At, 1, 1); PG8_STAGE(PG8_SB(1, 0), b3, voffB); PG8_STAGE(PG8_SB(1, 1), b3 + hstep, voffB); PG8_STAGE(PG8_SA(1, 0), a3, voffA);
            PG8_WAIT_V(8); PG8_WAIT_L(0); PG8_BAR; PG8_MMA(1, 0, At, B0); PG8_MMA(1, 1, At, B1); PG8_BAR; PG8_SCHED;
            } else {
            PG8_LDB(B0, 0, 0); PG8_SCHED; PG8_LDA(At, 0, 0); PG8_STAGE(PG8_SA(1, 1), a1 + hstep, voffA);
            PG8_WAIT_L(8); PG8_BAR; PG8_WAIT_L(0); PG8_MMA(0, 0, At, B0); PG8_BAR; PG8_SCHED;
            PG8_LDB(B1, 0, 1); PG8_STAGE(PG8_SB(0, 0), b2, voffB);
            PG8_BAR; PG8_WAIT_L(0); PG8_MMA(0, 1, At, B1); PG8_BAR;
            PG8_LDA(At, 0, 1); PG8_STAGE(PG8_SA(0, 0), a2, voffA);
            PG8_BAR; PG8_WAIT_L(0); PG8_MMA(1, 0, At, B0); PG8_BAR; PG8_SCHED;
            PG8_STAGE(PG8_SB(0, 1), b2 + hstep, voffB);
            PG8_WAIT_V(6); PG8_BAR; PG8_MMA(1, 1, At, B1); PG8_BAR;
            PG8_LDB(B0, 1, 0); PG8_SCHED; PG8_LDA(At, 1, 0); PG8_STAGE(PG8_SA(0, 1), a2 + hstep, voffA);
            PG8_WAIT_L(8); PG8_BAR; PG8_WAIT_L(0); PG8_MMA(0, 0, At, B0); PG8_BAR; PG8_SCHED;
            PG8_LDB(B1, 1, 1); PG8_STAGE(PG8_SB(1, 0), b3, voffB);
            PG8_BAR; PG8_WAIT_L(0); PG8_MMA(0, 1, At, B1); PG8_BAR;
            PG8_LDA(At, 1, 1); PG8_STAGE(PG8_SA(1, 0), a3, voffA);
            PG8_BAR; PG8_WAIT_L(0); PG8_MMA(1, 0, At, B0); PG8_BAR; PG8_SCHED;
            PG8_STAGE(PG8_SB(1, 1), b3 + hstep, voffB);
            PG8_WAIT_V(6); PG8_BAR; PG8_MMA(1, 1, At, B1); PG8_BAR;
            }
        }
        if constexpr (ALIGN_EPI) { if (wr == 0) PG8_BAR; }
        if constexpr (!Epi::AFTER_DRAIN) { E(acc, cur, wr, wc, fr, fq); S.done(cur); }
        if (!has_next) break;
#pragma unroll
        for (int a = 0; a < 2; ++a)
#pragma unroll
            for (int b = 0; b < 2; ++b)
#pragma unroll
                for (int m = 0; m < 4; ++m)
#pragma unroll
                    for (int n = 0; n < 2; ++n) acc[a][b][m][n] = (f32x4){0.f, 0.f, 0.f, 0.f};
        cur = nxt; cA = nA; cB = nB; ++ui;
        if constexpr (ALIGN_EPI) { if (wr == 1) PG8_BAR; }
    }
    PG8_WAIT_V(0);
    if constexpr (!ALIGN_EPI) { if (wr == 0) PG8_BAR; }
    PG8_BAR;
    if constexpr (Epi::AFTER_DRAIN) { E.fused(acc, cur, wr, wc, fr, fq, lds, wid, lane); S.done(cur); }
#undef PG8_SA
#undef PG8_SB
#undef PG8_STAGE
#undef PG8_LDA
#undef PG8_LDB
#undef PG8_MMA
#undef PG8_WAIT_V
#undef PG8_WAIT_L
#undef PG8_BAR
#undef PG8_SCHED
}
}
#define GAS __attribute__((address_space(1)))
#define LAS __attribute__((address_space(3)))
typedef unsigned short bf16;
typedef unsigned v4u __attribute__((ext_vector_type(4)));
typedef float f32x4 __attribute__((ext_vector_type(4)));
typedef short bf16x8 __attribute__((ext_vector_type(8)));
typedef GAS unsigned gu32;
typedef GAS unsigned long long gu64;
#define RLX_AGENT __ATOMIC_RELAXED, __HIP_MEMORY_SCOPE_AGENT
#define LDS_WAIT() asm volatile("s_waitcnt lgkmcnt(0)" ::: "memory")
#define VM_WAIT() asm volatile("s_waitcnt vmcnt(0)" ::: "memory")
__device__ __forceinline__ unsigned long long rt() { return __builtin_amdgcn_s_memrealtime(); }
__device__ __forceinline__ unsigned f2bf(float f) { unsigned u = __builtin_bit_cast(unsigned, f); return (u + 0x7fffu + ((u >> 16) & 1u)) >> 16; }
__device__ __forceinline__ unsigned pk2(float lo, float hi) { return f2bf(lo) | (f2bf(hi) << 16); }

#define XB_TMO      128
#define XB_XCNT(j)  (256  + 64 * (j))
#define XB_XSUB(j)  (1280 + 64 * (j))
#define XB_XGEN(j)  (2304 + 64 * (j))
#define XB_TOP      3328
#define XB_TOPGEN   3392
#define XCD_BAR_WORDS 3456
#define XB_SPIN_CAP (1u << 21)

__device__ __forceinline__ unsigned xb_ld(unsigned* p)              { return __hip_atomic_load(p, __ATOMIC_RELAXED, __HIP_MEMORY_SCOPE_AGENT); }
__device__ __forceinline__ unsigned xb_add(unsigned* p, unsigned v) { return __hip_atomic_fetch_add(p, v, __ATOMIC_RELAXED, __HIP_MEMORY_SCOPE_AGENT); }
__device__ __forceinline__ unsigned xb_xcc_id() { return (unsigned)__builtin_amdgcn_s_getreg((3 << 11) | 20) & 0xFu; }
#define XB_SPIN(cond, bar) do { unsigned _sp = 0; while (cond) { __builtin_amdgcn_s_sleep(1); \
    if ((++_sp & 255u) == 0u) { if (xb_ld(&(bar)[XB_TMO])) break; if (_sp > XB_SPIN_CAP) { atomicAdd(&(bar)[XB_TMO], 1u); break; } } } } while (0)

struct XcdBarrier {
    unsigned* bar; unsigned x;
    volatile LAS unsigned* st;
};

__device__ __forceinline__ XcdBarrier xcd_barrier_post(unsigned* bar, volatile LAS unsigned* st) {
    XcdBarrier b; b.bar = bar; b.x = xb_xcc_id(); b.st = st;
    if (threadIdx.x == 0) (void)xb_add(&bar[XB_XCNT(b.x)], 1u);
    return b;
}
__device__ __forceinline__ void xcd_barrier_complete(unsigned* bar, unsigned x, unsigned& nloc, unsigned& nx) {
    const unsigned G = gridDim.x * gridDim.y * gridDim.z;
    unsigned sum, cnt, mine, sp = 0u;
    for (;;) {
        sum = 0u; cnt = 0u; mine = 0u;
#pragma unroll
        for (unsigned j = 0; j < 16; ++j) { const unsigned c = xb_ld(&bar[XB_XCNT(j)]); sum += c; cnt += (c > 0u) ? 1u : 0u; mine = (j == x) ? c : mine; }
        if (sum == G) break;
        __builtin_amdgcn_s_sleep(1);
        if ((++sp & 255u) == 0u) { if (xb_ld(&bar[XB_TMO])) break; if (sp > XB_SPIN_CAP) { atomicAdd(&bar[XB_TMO], 1u); break; } }
    }
    nloc = mine > 0u ? mine : 1u; nx = cnt > 0u ? cnt : 1u;
}

__device__ __forceinline__ void xcd_barrier(const XcdBarrier& b) {
    asm volatile("s_waitcnt vmcnt(0)" ::: "memory");
    __syncthreads();
    if (threadIdx.x == 0) {
        unsigned* bar = b.bar;
        __builtin_amdgcn_s_waitcnt(0);
        unsigned nloc = b.st[0], nx = b.st[1];
        if (nloc == 0u) { xcd_barrier_complete(bar, b.x, nloc, nx); b.st[0] = nloc; b.st[1] = nx; }
        const unsigned old = xb_add(&bar[XB_XSUB(b.x)], 1u);
        const unsigned gen = old / nloc;
        if (old + 1u == (gen + 1u) * nloc) {
            __builtin_amdgcn_fence(__ATOMIC_RELEASE, "agent");
            asm volatile("s_waitcnt vmcnt(0)" ::: "memory");
            const unsigned og = xb_add(&bar[XB_TOP], 1u);
            const unsigned tg = og / nx;
            if (og + 1u == (tg + 1u) * nx) xb_add(&bar[XB_TOPGEN], 1u);
            else XB_SPIN(xb_ld(&bar[XB_TOPGEN]) == tg, bar);
            __builtin_amdgcn_fence(__ATOMIC_ACQUIRE, "agent");
            xb_add(&bar[XB_XGEN(b.x)], 1u);
            asm volatile("s_waitcnt vmcnt(0)" ::: "memory");
        } else {
            XB_SPIN(xb_ld(&bar[XB_XGEN(b.x)]) == gen, bar);
            __builtin_amdgcn_fence(__ATOMIC_ACQUIRE, "agent");
            asm volatile("s_waitcnt vmcnt(0)" ::: "memory");
        }
    }
    __syncthreads();
}

constexpr int NWAVES = 8;
constexpr int BATCH = 8, SEQ = 4096, D = 1024, M = BATCH * SEQ;
constexpr int DIN = 2048, CONVW = 512, SGWD = 512, NHEAD = 8, CKER = 31, CHUNK = 128;
constexpr int PHEADS = 8, TOPK = 16, NKEYS = 128, NEXP = 16384, PLE = 256, NSEL = PHEADS * TOPK;
constexpr float ALPHA = 1.18920711500272f;
constexpr float LN_EPS = 1e-5f;

constexpr size_t MiB = 1u << 20;
constexpr size_t WS_CTL = 0, CTL_ZERO_BYTES = 1 * MiB;
constexpr size_t WS_WIN = 2 * MiB, WS_WO = 6 * MiB, WS_WQ = 8 * MiB, WS_WG = 12 * MiB, WS_WP = 14 * MiB, WS_KEYS = 14 * MiB + 512 * 1024, WS_SGW = 15 * MiB, WS_BINP = 15 * MiB + 512 * 1024;
constexpr size_t WS_UT = 16 * MiB, WS_VT = 48 * MiB;
constexpr size_t WS_XN = 96 * MiB, WS_H1 = WS_XN;
constexpr size_t WS_PB = 160 * MiB;
constexpr size_t WS_CB = 176 * MiB, WS_GU = 208 * MiB, WS_VN = 240 * MiB;
constexpr size_t WS_PP = 176 * MiB, WS_IDX = 240 * MiB, WS_GW = 256 * MiB;
constexpr size_t WS_MIX = 272 * MiB, WS_GP = WS_MIX;
constexpr size_t WS_Z = 336 * MiB, WS_MIXO = WS_Z, WS_Q = WS_Z;
constexpr size_t WS_END = 464 * MiB;
constexpr int CW_BAR = 4096;

constexpr int RING_OFF = 0, RING_BYTES = 131072;
constexpr int LDSCTL_OFF = RING_BYTES, MISC_OFF = LDSCTL_OFF + 320;
constexpr int LDS_BYTES = 147456;

__device__ __forceinline__ float bf_lo(unsigned u) { return __uint_as_float(u << 16); }
__device__ __forceinline__ float bf_hi(unsigned u) { return __uint_as_float(u & 0xffff0000u); }
__device__ __forceinline__ float wave_sum(float v) {
#pragma unroll
    for (int o = 1; o < 64; o <<= 1) v += __shfl_xor(v, o);
    return v;
}
__device__ __forceinline__ float sigmoidf_(float x) { return 1.f / (1.f + __expf(-x)); }
__device__ __forceinline__ float gelu_exact(float x) { return 0.5f * x * (1.f + erff(x * 0.70710678118654752f)); }

__host__ __device__ __forceinline__ int win_src(int np) {
    const int j = np >> 8, lc = np & 255;
    if (j < 4) return (lc < 128) ? (128 * j + lc) : (512 + 128 * j + (lc - 128));
    const int jj = j - 4, base = (jj < 2) ? 1024 : 1536, head = 4 * (jj & 1) + ((lc >> 5) & 3), ch = 32 * (lc >> 7) + (lc & 31);
    return base + head * 64 + ch;
}

template <bool PERMW>
__device__ __forceinline__ void p0_transpose_item(const float* W, int K, int N, bf16* WT, LAS float* scr, int item, int lane) {
    const int nblk = N / 32, kb = item / nblk, nb = item % nblk, k0 = 64 * kb, n0d = 32 * nb, n0s = PERMW ? win_src(n0d) : n0d;
#pragma unroll 8
    for (int i = 0; i < 32; ++i) { const int kk = 2 * i + (lane >> 5); scr[kk * 33 + (lane & 31)] = W[(size_t)(k0 + kk) * N + n0s + (lane & 31)]; }
    LDS_WAIT(); asm volatile("" ::: "memory");
    const int c = lane & 7;
#pragma unroll
    for (int j = 0; j < 4; ++j) { const int n = (lane >> 3) + 8 * j; const LAS float* s = scr + (8 * c) * 33 + n;
        v4u o; o.x = pk2(s[0 * 33], s[1 * 33]); o.y = pk2(s[2 * 33], s[3 * 33]); o.z = pk2(s[4 * 33], s[5 * 33]); o.w = pk2(s[6 * 33], s[7 * 33]);
        *(GAS v4u*)(WT + (size_t)(n0d + n) * K + k0 + 8 * c) = o; }
    LDS_WAIT(); asm volatile("" ::: "memory");
}

typedef unsigned u32x2 __attribute__((ext_vector_type(2)));
typedef float f32x16 __attribute__((ext_vector_type(16)));

__device__ __forceinline__ void cvt_f32_bf16(const float* src, bf16* dst, size_t n4, size_t gtid, size_t nthr) {
    for (size_t i = gtid; i < n4; i += nthr) { const f32x4 v = ((const f32x4*)src)[i]; u32x2 o; o.x = pk2(v.x, v.y); o.y = pk2(v.z, v.w); ((u32x2*)dst)[i] = o; }
}

__device__ __forceinline__ void ln16(f32x4 (&v)[4], const float* g, const float* b, int lane) {
    float s = 0.f;
#pragma unroll
    for (int j = 0; j < 4; ++j) s += (v[j].x + v[j].y) + (v[j].z + v[j].w);
    const float mean = wave_sum(s) * (1.f / D); float s2 = 0.f;
#pragma unroll
    for (int j = 0; j < 4; ++j) { v[j] = v[j] - mean; s2 += (v[j].x * v[j].x + v[j].y * v[j].y) + (v[j].z * v[j].z + v[j].w * v[j].w); }
    const float rstd = 1.f / sqrtf(wave_sum(s2) * (1.f / D) + LN_EPS);
#pragma unroll
    for (int j = 0; j < 4; ++j) { const f32x4 gg = ((const f32x4*)g)[lane + 64 * j], bb = ((const f32x4*)b)[lane + 64 * j]; v[j] = v[j] * rstd * gg + bb; }
}
__device__ __forceinline__ void store_bf16_row16(bf16* orow, const f32x4 (&v)[4], int lane) {
#pragma unroll
    for (int j = 0; j < 4; ++j) { u32x2 o; o.x = pk2(v[j].x, v[j].y); o.y = pk2(v[j].z, v[j].w); ((u32x2*)orow)[lane + 64 * j] = o; }
}
__device__ __forceinline__ void load_bf16_row16(const bf16* row, f32x4 (&v)[4], int lane) {
#pragma unroll
    for (int j = 0; j < 4; ++j) { const u32x2 u = ((const u32x2*)row)[lane + 64 * j]; v[j] = (f32x4){bf_lo(u.x), bf_hi(u.x), bf_lo(u.y), bf_hi(u.y)}; }
}
__device__ __forceinline__ void unpack8(const v4u u, float (&f)[8]) {
    f[0] = bf_lo(u.x); f[1] = bf_hi(u.x); f[2] = bf_lo(u.y); f[3] = bf_hi(u.y); f[4] = bf_lo(u.z); f[5] = bf_hi(u.z); f[6] = bf_lo(u.w); f[7] = bf_hi(u.w);
}
__device__ __forceinline__ v4u pack8(const float (&f)[8]) { v4u o; o.x = pk2(f[0], f[1]); o.y = pk2(f[2], f[3]); o.z = pk2(f[4], f[5]); o.w = pk2(f[6], f[7]); return o; }


__device__ __forceinline__ int f2key(float f) { const int b = __float_as_int(f); return b ^ ((b >> 31) & 0x7fffffff); }
__device__ __forceinline__ float key2f(int k) { return __int_as_float(k ^ ((k >> 31) & 0x7fffffff)); }
#define CE_DESC(a, b) do { const int _mx = max((a), (b)), _mn = min((a), (b)); (a) = _mx; (b) = _mn; } while (0)
__device__ __forceinline__ void sort16_desc(int (&a)[16]) {
#pragma unroll
    for (int k = 2; k <= 16; k <<= 1)
#pragma unroll
        for (int j = k >> 1; j > 0; j >>= 1)
#pragma unroll
            for (int i = 0; i < 16; ++i) { const int l = i ^ j; if (l > i) { if ((i & k) == 0) CE_DESC(a[i], a[l]); else CE_DESC(a[l], a[i]); } }
}
__device__ __forceinline__ void merge16_desc(int (&a)[16], const int (&b)[16]) {
#pragma unroll
    for (int i = 0; i < 16; ++i) a[i] = max(a[i], b[15 - i]);
#pragma unroll
    for (int j = 8; j > 0; j >>= 1)
#pragma unroll
        for (int i = 0; i < 16; ++i) { const int l = i ^ j; if (l > i) CE_DESC(a[i], a[l]); }
}

struct Args { const float* in[27]; float* out; unsigned char* ws; };

__global__ void __launch_bounds__(NWAVES * 64, 2) fwd_kernel(Args args) {
    extern __shared__ __attribute__((aligned(16))) unsigned char lds_raw[];
    LAS unsigned char* lds = (LAS unsigned char*)lds_raw;
    volatile LAS unsigned* MISC = (volatile LAS unsigned*)(lds + MISC_OFF);
    const int tid = threadIdx.x, lane = tid & 63, wave = __builtin_amdgcn_readfirstlane(tid >> 6);
    const int G = gridDim.x; const int bx = blockIdx.x; const int vcu = (G % 8 == 0) ? (bx % 8) * (G / 8) + bx / 8 : bx;
    const int gw = vcu * NWAVES + wave, NGW = G * NWAVES;
    const size_t gtid = (size_t)gw * 64 + lane, nthr = (size_t)NGW * 64;
    unsigned char* ws = args.ws;
    gu32* ctl = (gu32*)(ws + WS_CTL);
    for (int u = tid; u < (LDS_BYTES - LDSCTL_OFF) / 4; u += NWAVES * 64) ((LAS unsigned*)(lds + LDSCTL_OFF))[u] = 0u;
    __syncthreads();
    XcdBarrier bar = xcd_barrier_post((unsigned*)(ctl + CW_BAR), MISC + 8);
#define GRID_BAR() xcd_barrier(bar)

    const float* x = args.in[0]; const float* p_in = args.in[1];
    const float *ln0_g = args.in[2], *ln0_b = args.in[3], *w_in = args.in[4], *b_in = args.in[5], *conv_w = args.in[6], *conv_b = args.in[7], *gn_g = args.in[8], *gn_b = args.in[9];
    const float *sg_ln_g = args.in[10], *sg_ln_b = args.in[11], *sg_w = args.in[12], *sg_b = args.in[13], *w_o = args.in[14], *b_o = args.in[15], *ln1_g = args.in[16], *ln1_b = args.in[17];
    const float *peer_wq = args.in[18], *peer_keys = args.in[19], *peer_u = args.in[20], *peer_v = args.in[21], *ple_wp = args.in[22], *ple_wg = args.in[23], *ple_bg = args.in[24], *ln2_g = args.in[25], *ln2_b = args.in[26];
    bf16 *WIN = (bf16*)(ws + WS_WIN), *WO = (bf16*)(ws + WS_WO), *WQ = (bf16*)(ws + WS_WQ), *WG = (bf16*)(ws + WS_WG), *WP = (bf16*)(ws + WS_WP), *KEYS = (bf16*)(ws + WS_KEYS), *SGW = (bf16*)(ws + WS_SGW);
    float* BINP = (float*)(ws + WS_BINP);
    bf16 *UT = (bf16*)(ws + WS_UT), *VT = (bf16*)(ws + WS_VT), *XN = (bf16*)(ws + WS_XN), *H1 = (bf16*)(ws + WS_H1), *PB = (bf16*)(ws + WS_PB);
    bf16 *CB = (bf16*)(ws + WS_CB), *GU = (bf16*)(ws + WS_GU), *VN = (bf16*)(ws + WS_VN), *PP = (bf16*)(ws + WS_PP), *MIX = (bf16*)(ws + WS_MIX), *GP = (bf16*)(ws + WS_GP);
    bf16 *Z = (bf16*)(ws + WS_Z), *MIXO = (bf16*)(ws + WS_MIXO), *Q = (bf16*)(ws + WS_Q);
    int* IDX = (int*)(ws + WS_IDX); float* GWT = (float*)(ws + WS_GW);

    {
        LAS float* scr = (LAS float*)(lds + RING_OFF + wave * 16384);
        constexpr int I_IN = (D / 64) * (DIN / 32), I_O = (D / 64) * (D / 32), I_Q = (D / 64) * (2048 / 32), I_G = I_O, I_P = (PLE / 64) * (D / 32);
        constexpr int NITEMS = I_IN + I_O + I_Q + I_G + I_P;
        for (int it = gw; it < NITEMS; it += NGW) {
            int r = it;
            if (r < I_IN) { p0_transpose_item<true>(w_in, D, DIN, WIN, scr, r, lane); continue; } r -= I_IN;
            if (r < I_O) { p0_transpose_item<false>(w_o, D, D, WO, scr, r, lane); continue; } r -= I_O;
            if (r < I_Q) { p0_transpose_item<false>(peer_wq, D, 2048, WQ, scr, r, lane); continue; } r -= I_Q;
            if (r < I_G) { p0_transpose_item<false>(ple_wg, D, D, WG, scr, r, lane); continue; } r -= I_G;
            p0_transpose_item<false>(ple_wp, PLE, D, WP, scr, r, lane);
        }
        for (size_t i = gtid; i < DIN; i += nthr) BINP[i] = b_in[win_src((int)i)];
        cvt_f32_bf16(peer_keys, KEYS, (size_t)PHEADS * 2 * NKEYS * 128 / 4, gtid, nthr);
        cvt_f32_bf16(peer_u, UT, (size_t)NEXP * D / 4, gtid, nthr);
        cvt_f32_bf16(peer_v, VT, (size_t)NEXP * D / 4, gtid, nthr);
        cvt_f32_bf16(p_in, PB, (size_t)M * PLE / 4, gtid, nthr);
        for (size_t i = gtid; i < (size_t)NHEAD * CHUNK * CHUNK / 4; i += nthr) {
            const f32x4 v = ((const f32x4*)sg_w)[i]; const int e = (int)(i * 4), t = (e >> 7) & 127, s = e & 127;
            u32x2 o; o.x = pk2(s <= t ? v.x : 0.f, s + 1 <= t ? v.y : 0.f); o.y = pk2(s + 2 <= t ? v.z : 0.f, s + 3 <= t ? v.w : 0.f); ((u32x2*)SGW)[i] = o; }
        for (int m = gw; m < M; m += NGW) {
            f32x4 v[4];
#pragma unroll
            for (int j = 0; j < 4; ++j) v[j] = ((const f32x4*)(x + (size_t)m * D))[lane + 64 * j];
            ln16(v, ln0_g, ln0_b, lane); store_bf16_row16(XN + (size_t)m * D, v, lane);
        }
    }
    GRID_BAR();
    {
        pg8::Gemm g{XN, WIN, M, DIN, D}; pg8::StaticOrder S; S.init(M, DIN, G, bx);
        pg8::EpiBf16<0> E{Z, DIN, BINP, 0, 0, 1.f};
        pg8::gemm_phase<pg8::EpiBf16<0>, pg8::StaticOrder, true, true>(lds + RING_OFF, g, S, E);
    }
    GRID_BAR();
    for (int m = gw; m < M; m += NGW) {
        const bf16* z = Z + (size_t)m * DIN;
        { const int c0 = 8 * lane, j = c0 >> 7, lc = c0 & 127; float a[8], gt[8];
          unpack8(*(const v4u*)(z + 256 * j + lc), a); unpack8(*(const v4u*)(z + 256 * j + 128 + lc), gt);
#pragma unroll
          for (int i = 0; i < 8; ++i) a[i] = a[i] * sigmoidf_(gt[i]);
          *(v4u*)(CB + (size_t)m * CONVW + c0) = pack8(a); }
        { const int h = lane >> 3, ch0 = 8 * (lane & 7), lcs = 128 * (ch0 >> 5) + 32 * (h & 3) + (ch0 & 31); float u[8], v[8];
          unpack8(*(const v4u*)(z + 256 * (4 + (h >> 2)) + lcs), u); unpack8(*(const v4u*)(z + 256 * (6 + (h >> 2)) + lcs), v);
          float s = 0.f;
#pragma unroll
          for (int i = 0; i < 8; ++i) { u[i] = gelu_exact(u[i]); v[i] = gelu_exact(v[i]); s += v[i]; }
          *(v4u*)(GU + (size_t)m * SGWD + h * 64 + ch0) = pack8(u);
          s += __shfl_xor(s, 1); s += __shfl_xor(s, 2); s += __shfl_xor(s, 4);
          const float mean = s * (1.f / 64.f); float q = 0.f;
#pragma unroll
          for (int i = 0; i < 8; ++i) { v[i] -= mean; q += v[i] * v[i]; }
          q += __shfl_xor(q, 1); q += __shfl_xor(q, 2); q += __shfl_xor(q, 4);
          const float rstd = 1.f / sqrtf(q * (1.f / 64.f) + LN_EPS);
#pragma unroll
          for (int i = 0; i < 8; ++i) v[i] = v[i] * rstd * sg_ln_g[h * 64 + ch0 + i] + sg_ln_b[h * 64 + ch0 + i];
          *(v4u*)(VN + (size_t)m * SGWD + h * 64 + ch0) = pack8(v); }
    }
    GRID_BAR();
    for (int m = gw; m < M; m += NGW) {
        const int t = m & (SEQ - 1), c0 = 8 * lane; float acc[8];
#pragma unroll
        for (int i = 0; i < 8; ++i) acc[i] = conv_b[c0 + i];
        for (int j = 0; j < CKER; ++j) { if (t - (CKER - 1) + j < 0) continue;
            float xv[8]; unpack8(*(const v4u*)(CB + (size_t)(m - (CKER - 1) + j) * CONVW + c0), xv);
            const f32x4 w0 = *(const f32x4*)(conv_w + j * CONVW + c0), w1 = *(const f32x4*)(conv_w + j * CONVW + c0 + 4);
            acc[0] += w0.x * xv[0]; acc[1] += w0.y * xv[1]; acc[2] += w0.z * xv[2]; acc[3] += w0.w * xv[3];
            acc[4] += w1.x * xv[4]; acc[5] += w1.y * xv[5]; acc[6] += w1.z * xv[6]; acc[7] += w1.w * xv[7]; }
        float s = 0.f;
#pragma unroll
        for (int i = 0; i < 8; ++i) s += acc[i];
        s += __shfl_xor(s, 1); s += __shfl_xor(s, 2); s += __shfl_xor(s, 4);
        const float mean = s * (1.f / 64.f); float q = 0.f;
#pragma unroll
        for (int i = 0; i < 8; ++i) { acc[i] -= mean; q += acc[i] * acc[i]; }
        q += __shfl_xor(q, 1); q += __shfl_xor(q, 2); q += __shfl_xor(q, 4);
        const float rstd = 1.f / sqrtf(q * (1.f / 64.f) + LN_EPS);
#pragma unroll
        for (int i = 0; i < 8; ++i) { const float y = acc[i] * rstd * gn_g[c0 + i] + gn_b[c0 + i]; acc[i] = y * sigmoidf_(y); }
        *(v4u*)(MIX + (size_t)m * D + c0) = pack8(acc);
    }
    for (int ch = vcu; ch < M / CHUNK; ch += G) {
        const int h = wave, r31 = lane & 31, hh = lane >> 5;
        LAS unsigned char* T = lds + RING_OFF + wave * 16384;
#pragma unroll 4
        for (int i = 0; i < 16; ++i) { const int e = lane + 64 * i, s = e >> 3, dc = e & 7;
            const v4u v = *(const v4u*)(VN + (size_t)(ch * CHUNK + s) * SGWD + h * 64 + dc * 8);
            const unsigned w[4] = {v.x, v.y, v.z, v.w};
#pragma unroll
            for (int k = 0; k < 8; ++k) { const int d = dc * 8 + k; const unsigned short val = (unsigned short)((k & 1) ? (w[k >> 1] >> 16) : (w[k >> 1] & 0xffffu));
                *(LAS unsigned short*)(T + d * 256 + (((s >> 3) ^ (d & 15)) << 4) + (s & 7) * 2) = val; } }
        LDS_WAIT(); asm volatile("" ::: "memory");
        f32x16 acc[2][4];
#pragma unroll
        for (int a = 0; a < 2; ++a)
#pragma unroll
            for (int b = 0; b < 4; ++b)
#pragma unroll
                for (int r = 0; r < 16; ++r) acc[a][b][r] = 0.f;
#pragma unroll 2
        for (int step = 0; step < 8; ++step) {
            bf16x8 A[2], B[4];
#pragma unroll
            for (int dm = 0; dm < 2; ++dm) { const int d = 32 * dm + r31; A[dm] = *(const LAS bf16x8*)(T + d * 256 + (((2 * step + hh) ^ (d & 15)) << 4)); }
#pragma unroll
            for (int tn = 0; tn < 4; ++tn) B[tn] = *(const bf16x8*)(SGW + ((size_t)h * CHUNK + 32 * tn + r31) * CHUNK + 16 * step + 8 * hh);
#pragma unroll
            for (int dm = 0; dm < 2; ++dm)
#pragma unroll
                for (int tn = 0; tn < 4; ++tn) acc[dm][tn] = __builtin_amdgcn_mfma_f32_32x32x16_bf16(A[dm], B[tn], acc[dm][tn], 0, 0, 0);
        }
#pragma unroll
        for (int tn = 0; tn < 4; ++tn) { const int t = 32 * tn + r31; const size_t m = (size_t)ch * CHUNK + t; const float bias = sg_b[h * CHUNK + t];
#pragma unroll
            for (int dm = 0; dm < 2; ++dm)
#pragma unroll
                for (int rq = 0; rq < 4; ++rq) { const int d0 = 32 * dm + 8 * rq + 4 * hh;
                    const u32x2 gu = *(const u32x2*)(GU + m * SGWD + h * 64 + d0);
                    u32x2 o; o.x = pk2(bf_lo(gu.x) * (acc[dm][tn][4 * rq + 0] + bias), bf_hi(gu.x) * (acc[dm][tn][4 * rq + 1] + bias));
                    o.y = pk2(bf_lo(gu.y) * (acc[dm][tn][4 * rq + 2] + bias), bf_hi(gu.y) * (acc[dm][tn][4 * rq + 3] + bias));
                    *(u32x2*)(MIX + m * D + 512 + h * 64 + d0) = o; } }
        LDS_WAIT(); asm volatile("" ::: "memory");
    }
    GRID_BAR();
    {
        pg8::Gemm g{MIX, WO, M, D, D}; pg8::StaticOrder S; S.init(M, D, G, bx);
        pg8::EpiBf16<0> E{MIXO, D, b_o, 0, 0, 1.f};
        pg8::gemm_phase<pg8::EpiBf16<0>, pg8::StaticOrder, true, true>(lds + RING_OFF, g, S, E);
    }
    GRID_BAR();
    for (int m = gw; m < M; m += NGW) {
        f32x4 a[4], b[4]; load_bf16_row16(XN + (size_t)m * D, a, lane); load_bf16_row16(MIXO + (size_t)m * D, b, lane);
#pragma unroll
        for (int j = 0; j < 4; ++j) a[j] = a[j] * ALPHA + b[j];
        ln16(a, ln1_g, ln1_b, lane); store_bf16_row16(H1 + (size_t)m * D, a, lane);
    }
    GRID_BAR();
    {
        { pg8::Gemm g{H1, WQ, M, 2048, D}; pg8::StaticOrder S; S.init(M, 2048, G, bx); pg8::EpiBf16<0> E{Q, 2048, nullptr, 0, 0, 1.f};
          pg8::gemm_phase<pg8::EpiBf16<0>, pg8::StaticOrder, true, true>(lds + RING_OFF, g, S, E); }
        { pg8::Gemm g{H1, WG, M, D, D}; pg8::StaticOrder S; S.init(M, D, G, bx); pg8::EpiBf16<0> E{GP, D, ple_bg, 0, 0, 1.f};
          pg8::gemm_phase<pg8::EpiBf16<0>, pg8::StaticOrder, true, true>(lds + RING_OFF, g, S, E); }
        { pg8::Gemm g{PB, WP, M, D, PLE}; pg8::StaticOrder S; S.init(M, D, G, bx); pg8::EpiBf16<0> E{PP, D, nullptr, 0, 0, 1.f};
          pg8::gemm_phase<pg8::EpiBf16<0>, pg8::StaticOrder, true, true>(lds + RING_OFF, g, S, E); }
    }
    GRID_BAR();
    for (int u = gw; u < (M / 32) * PHEADS; u += NGW) {
        const int tg = u >> 3, h = u & 7, r31 = lane & 31, hh = lane >> 5; const size_t tok = (size_t)tg * 32 + r31;
        int t12[2][16];
#pragma unroll
        for (int half = 0; half < 2; ++half) {
            f32x16 acc[4];
#pragma unroll
            for (int kb = 0; kb < 4; ++kb)
#pragma unroll
                for (int r = 0; r < 16; ++r) acc[kb][r] = 0.f;
#pragma unroll 2
            for (int step = 0; step < 8; ++step) {
                const bf16x8 B = *(const bf16x8*)(Q + tok * 2048 + h * 256 + half * 128 + 16 * step + 8 * hh);
#pragma unroll
                for (int kb = 0; kb < 4; ++kb) { const bf16x8 A = *(const bf16x8*)(KEYS + ((size_t)(h * 2 + half) * NKEYS + 32 * kb + r31) * 128 + 16 * step + 8 * hh);
                    acc[kb] = __builtin_amdgcn_mfma_f32_32x32x16_bf16(A, B, acc[kb], 0, 0, 0); }
            }
            int g[4][16];
#pragma unroll
            for (int kb = 0; kb < 4; ++kb) {
#pragma unroll
                for (int r = 0; r < 16; ++r) { const int key = 32 * kb + (r & 3) + 8 * (r >> 2) + 4 * hh; g[kb][r] = (f2key(acc[kb][r]) & ~127) | key; }
                sort16_desc(g[kb]); }
            merge16_desc(g[0], g[1]); merge16_desc(g[2], g[3]); merge16_desc(g[0], g[2]);
            int o[16];
#pragma unroll
            for (int i = 0; i < 16; ++i) o[i] = __shfl_xor(g[0][i], 32);
            merge16_desc(g[0], o);
#pragma unroll
            for (int i = 0; i < 16; ++i) t12[half][i] = g[0][i];
        }
        LAS unsigned char* tab = lds + RING_OFF + wave * 16384 + lane * 36;
#pragma unroll
        for (int w = 0; w < 8; ++w) { const int hf = w >> 2, i0 = 4 * (w & 3);
            *(LAS unsigned*)(tab + 4 * w) = (unsigned)(t12[hf][i0] & 127) | ((unsigned)(t12[hf][i0 + 1] & 127) << 8) | ((unsigned)(t12[hf][i0 + 2] & 127) << 16) | ((unsigned)(t12[hf][i0 + 3] & 127) << 24); }
        float f1[16], f2[16];
#pragma unroll
        for (int i = 0; i < 16; ++i) { f1[i] = key2f(t12[0][i] & ~127); f2[i] = key2f(t12[1][i] & ~127); }
        int c[4][16];
#pragma unroll
        for (int gidx = 0; gidx < 4; ++gidx)
#pragma unroll
            for (int k = 0; k < 16; ++k) c[gidx][k] = (int)0x80000000;
#define CAND(gi, k, i, j) c[gi][k] = (f2key(f1[i] + f2[j]) & ~255) | ((i) * 16 + (j))
#pragma unroll
        for (int j = 0; j < 16; ++j) CAND(0, j, 0, j);
#pragma unroll
        for (int j = 0; j < 8; ++j) CAND(1, j, 1, j);
#pragma unroll
        for (int j = 0; j < 5; ++j) CAND(1, 8 + j, 2, j);
#pragma unroll
        for (int j = 0; j < 3; ++j) CAND(1, 13 + j, 4, j);
#pragma unroll
        for (int j = 0; j < 4; ++j) CAND(2, j, 3, j);
#pragma unroll
        for (int j = 0; j < 2; ++j) { CAND(2, 4 + j, 5, j); CAND(2, 6 + j, 6, j); CAND(2, 8 + j, 7, j); }
#pragma unroll
        for (int i = 8; i < 14; ++i) CAND(2, 10 + (i - 8), i, 0);
        CAND(3, 0, 14, 0); CAND(3, 1, 15, 0);
#undef CAND
        sort16_desc(c[1]); sort16_desc(c[2]); sort16_desc(c[3]);
        merge16_desc(c[0], c[1]); merge16_desc(c[0], c[2]); merge16_desc(c[0], c[3]);
        float sc[16]; int se[16];
        const float m0 = key2f(c[0][0] & ~255); float sum = 0.f;
#pragma unroll
        for (int it = 0; it < 16; ++it) { const int id = c[0][it] & 255; const int a = tab[id >> 4], b = tab[16 + (id & 15)];
            se[it] = a * NKEYS + b; sc[it] = __expf(key2f(c[0][it] & ~255) - m0); sum += sc[it]; }
        const float inv = 1.f / sum;
        if (hh == 0) {
            int* ip = IDX + tok * NSEL + h * TOPK; float* gp = GWT + tok * NSEL + h * TOPK;
#pragma unroll
            for (int it = 0; it < 16; ++it) { ip[it] = se[it]; gp[it] = sc[it] * inv; }
        }
    }
    GRID_BAR();
    for (int m = gw; m < M; m += NGW) {
        f32x4 hv[4]; load_bf16_row16(H1 + (size_t)m * D, hv, lane);
        const int e0 = IDX[(size_t)m * NSEL + lane], e1 = IDX[(size_t)m * NSEL + 64 + lane];
        const float g0 = GWT[(size_t)m * NSEL + lane], g1 = GWT[(size_t)m * NSEL + 64 + lane];
        f32x4 acc[4];
#pragma unroll
        for (int j = 0; j < 4; ++j) acc[j] = (f32x4){0.f, 0.f, 0.f, 0.f};
        for (int p = 0; p < NSEL; p += 4) {
            int e[4]; float gq[4]; u32x2 uu[4][4];
#pragma unroll
            for (int q = 0; q < 4; ++q) { const int pi = p + q; e[q] = __shfl(pi < 64 ? e0 : e1, pi & 63); gq[q] = __shfl(pi < 64 ? g0 : g1, pi & 63);
#pragma unroll
                for (int j = 0; j < 4; ++j) uu[q][j] = ((const u32x2*)(UT + (size_t)e[q] * D))[lane + 64 * j]; }
            float dt[4];
#pragma unroll
            for (int q = 0; q < 4; ++q) { float s = 0.f;
#pragma unroll
                for (int j = 0; j < 4; ++j) s += (bf_lo(uu[q][j].x) * hv[j].x + bf_hi(uu[q][j].x) * hv[j].y) + (bf_lo(uu[q][j].y) * hv[j].z + bf_hi(uu[q][j].y) * hv[j].w);
                dt[q] = s; }
#pragma unroll
            for (int o = 1; o < 64; o <<= 1) {
#pragma unroll
                for (int q = 0; q < 4; ++q) dt[q] += __shfl_xor(dt[q], o); }
#pragma unroll
            for (int q = 0; q < 4; ++q) { const float cf = gq[q] * gelu_exact(dt[q]);
#pragma unroll
                for (int j = 0; j < 4; ++j) { const u32x2 vv = ((const u32x2*)(VT + (size_t)e[q] * D))[lane + 64 * j];
                    acc[j].x += cf * bf_lo(vv.x); acc[j].y += cf * bf_hi(vv.x); acc[j].z += cf * bf_lo(vv.y); acc[j].w += cf * bf_hi(vv.y); } }
        }
        f32x4 gp[4], pp[4]; load_bf16_row16(GP + (size_t)m * D, gp, lane); load_bf16_row16(PP + (size_t)m * D, pp, lane);
#pragma unroll
        for (int j = 0; j < 4; ++j) {
            acc[j].x = hv[j].x * ALPHA + acc[j].x + sigmoidf_(gp[j].x) * pp[j].x; acc[j].y = hv[j].y * ALPHA + acc[j].y + sigmoidf_(gp[j].y) * pp[j].y;
            acc[j].z = hv[j].z * ALPHA + acc[j].z + sigmoidf_(gp[j].z) * pp[j].z; acc[j].w = hv[j].w * ALPHA + acc[j].w + sigmoidf_(gp[j].w) * pp[j].w; }
        ln16(acc, ln2_g, ln2_b, lane);
#pragma unroll
        for (int j = 0; j < 4; ++j) ((f32x4*)(args.out + (size_t)m * D))[lane + 64 * j] = acc[j];
    }
}

extern "C" void kernel_launch(void* const* d_in, const int* in_sizes, int n_in, void* d_out, int out_size, void* d_ws, size_t ws_size, hipStream_t stream) {
    static int grid = 0;
    if (grid == 0) {
        if (n_in != 27 || in_sizes[0] != M * D || out_size != M * D || ws_size < WS_END) { fprintf(stderr, "kernel_launch: unexpected shapes (n_in %d, in0 %d, out %d, ws %zu)\n", n_in, n_in > 0 ? in_sizes[0] : -1, out_size, ws_size); grid = -1; return; }
        int dev = 0, cus = 0, per_cu = 0;
        if (hipGetDevice(&dev) != hipSuccess || hipDeviceGetAttribute(&cus, hipDeviceAttributeMultiprocessorCount, dev) != hipSuccess) { grid = -1; return; }
        if (hipFuncSetAttribute((const void*)fwd_kernel, hipFuncAttributeMaxDynamicSharedMemorySize, LDS_BYTES) != hipSuccess) { fprintf(stderr, "kernel_launch: hipFuncSetAttribute failed\n"); grid = -1; return; }
        if (hipOccupancyMaxActiveBlocksPerMultiprocessor(&per_cu, (const void*)fwd_kernel, NWAVES * 64, LDS_BYTES) != hipSuccess || per_cu < 1) fprintf(stderr, "kernel_launch: occupancy query says %d\n", per_cu);
        (void)hipGetLastError();
        grid = cus;
    }
    if (grid < 0) return;
    if (hipMemsetAsync((char*)d_ws + WS_CTL, 0, CTL_ZERO_BYTES, stream) != hipSuccess) return;
    Args a{};
    for (int i = 0; i < 27; ++i) a.in[i] = (const float*)d_in[i];
    a.out = (float*)d_out; a.ws = (unsigned char*)d_ws;
    hipLaunchKernelGGL(fwd_kernel, dim3(grid), dim3(NWAVES * 64), LDS_BYTES, stream, a);
}
```

```cpp
#include <hip/hip_runtime.h>
#include <cstdio>
#include <cstdint>
namespace pg8 {
#define PG8_LAS __attribute__((address_space(3)))
typedef unsigned short bf16_t;
typedef short bf16x8 __attribute__((ext_vector_type(8)));
typedef float f32x4 __attribute__((ext_vector_type(4)));
typedef unsigned u32x4 __attribute__((ext_vector_type(4)));
constexpr int BM = 256, BK = 64, HALF = 128, HTB = HALF * BK * 2  , STAGE_BYTES = 8 * HTB, NXCD = 8, WGM = 8;

__host__ __device__ __forceinline__ int lds_byte(int r, int c) { const int st = (r >> 4) * 2 + (c >> 5), rr = r & 15, cc = c & 31, ob = rr * 64 + cc * 2; return st * 1024 + (ob ^ (((ob >> 9) & 1) << 5)); }
__host__ __device__ __forceinline__ void stage_rc(int b, int& R, int& C) { const int st = b / 1024, sb = b % 1024, swz = sb ^ (((sb >> 9) & 1) << 5); R = (st >> 1) * 16 + swz / 64; C = (st & 1) * 32 + (swz % 64) / 2; }
__host__ __device__ __forceinline__ int perm32(int rho) { const int n = rho >> 4, i = rho & 15; return 8 * (i >> 2) + 4 * n + (i & 3); }

struct Unit { int pm, pn; };
struct Gemm { const bf16_t* A; const bf16_t* Bt; int M, N, K; };

struct StaticOrder {
    int nM, nN, nwg, G, c;
    __host__ __device__ void init(int M, int N, int G_, int c_) { nM = M / BM; nN = N / BM; nwg = nM * nN; G = G_; c = c_; }
    __host__ __device__ bool next(int i, Unit& u) const {
        const long L = (long)i * G + c; if (L >= nwg) return false;
        int wgid = (int)L; { const int q = nwg / NXCD, r = nwg % NXCD, xcd = wgid % NXCD, off = wgid / NXCD; wgid = (xcd < r ? xcd * (q + 1) : r * (q + 1) + (xcd - r) * q) + off; }
        const int nig = WGM * nN, gid = wgid / nig, fm = gid * WGM, gsz = (nM - fm) < WGM ? (nM - fm) : WGM;
        u.pm = fm + ((wgid % nig) % gsz); u.pn = (wgid % nig) / gsz; return true;
    }
    __device__ __forceinline__ void a_ready(const Unit&) const {}
    __device__ __forceinline__ void done(const Unit&) const {}
};

__device__ __forceinline__ unsigned cvt_pk_bf16(float lo, float hi) { unsigned r; asm volatile("v_cvt_pk_bf16_f32 %0, %1, %2" : "=v"(r) : "v"(lo), "v"(hi)); return r; }
typedef float f32x2 __attribute__((ext_vector_type(2)));
__device__ __forceinline__ f32x2 gelu_pk(f32x2 v) {
    const f32x2 av = __builtin_elementwise_abs(v), d = av * 0.2316418882f + 1.0f;
    f32x2 t; t.x = __builtin_amdgcn_rcpf(d.x); t.y = __builtin_amdgcn_rcpf(d.y);
    f32x2 q = t * 0.5307027145f + (-0.7265760135f); q = q * t + 0.7107068705f; q = q * t + (-0.142248368f); q = q * t + 0.127414796f; q = q * t;
    const f32x2 s = (v * v) * (-0.72134752044f);
    f32x2 e; e.x = __builtin_amdgcn_exp2f(s.x); e.y = __builtin_amdgcn_exp2f(s.y);
    const f32x2 m = v * (q * e), r = v - m;
    f32x2 o; o.x = v.x < 0.f ? m.x : r.x; o.y = v.y < 0.f ? m.y : r.y; return o;
}

template <int ACT  > struct EpiBf16 {
    static constexpr bool PERM = true, AFTER_DRAIN = false; static_assert(ACT == 0 || ACT == 1, "EpiBf16: ACT is 0 (none) or 1 (gelu_pk)");
    bf16_t* O; int ldc; const float* bias; int split_cols; size_t split_stride; float scale0;
    __device__ __forceinline__ void operator()(const f32x4 (&acc)[2][2][4][2], const Unit& u, int wr, int wc, int fr, int fq) const {
        const int row0 = u.pm * BM + wr * 64 + fr; int colt = u.pn * BM; bf16_t* base = O;
        float sc = 1.f; if (split_cols) { const int t = colt / split_cols; base += (size_t)t * split_stride; colt -= t * split_cols; if (t == 0) sc = scale0; }
        const int col0 = colt + wc * 32 + 8 * fq, bcol0 = u.pn * BM + wc * 32 + 8 * fq;
        f32x4 bv[2][2];
#pragma unroll
        for (int bj = 0; bj < 2; ++bj)
#pragma unroll
            for (int n = 0; n < 2; ++n) bv[bj][n] = bias ? *(const f32x4*)(bias + bcol0 + bj * HALF + 4 * n) : (f32x4){0.f, 0.f, 0.f, 0.f};
#pragma unroll
        for (int ai = 0; ai < 2; ++ai)
#pragma unroll
            for (int m = 0; m < 4; ++m) { bf16_t* rowp = base + (size_t)(row0 + ai * HALF + m * 16) * ldc + col0;
#pragma unroll
                for (int bj = 0; bj < 2; ++bj) { f32x4 v0 = acc[ai][bj][m][0] + bv[bj][0], v1 = acc[ai][bj][m][1] + bv[bj][1];
                    if (ACT == 1) { f32x2 a = gelu_pk((f32x2){v0[0], v0[1]}), b = gelu_pk((f32x2){v0[2], v0[3]}), c = gelu_pk((f32x2){v1[0], v1[1]}), d = gelu_pk((f32x2){v1[2], v1[3]});
                        v0 = (f32x4){a.x, a.y, b.x, b.y}; v1 = (f32x4){c.x, c.y, d.x, d.y}; }
                    v0 = v0 * sc; v1 = v1 * sc; u32x4 w; w.x = cvt_pk_bf16(v0[0], v0[1]); w.y = cvt_pk_bf16(v0[2], v0[3]); w.z = cvt_pk_bf16(v1[0], v1[1]); w.w = cvt_pk_bf16(v1[2], v1[3]);
                    *(u32x4*)(rowp + bj * HALF) = w; } }
    }
};

template <class Epi, class Sched, bool ALIGN_EPI = false, bool SP2 = false>
__device__ __forceinline__ void gemm_phase(PG8_LAS unsigned char* lds, const Gemm g, const Sched& S, const Epi& E) {
    const int tid = threadIdx.x, wid = __builtin_amdgcn_readfirstlane(tid >> 6), lane = tid & 63, wr = wid >> 2, wc = wid & 3, fr = lane & 15, fq = lane >> 4;
    const int K = g.K, nt = K / BK;
    unsigned voffA[2], voffB[2];
#pragma unroll
    for (int i = 0; i < 2; ++i) { int R, C; stage_rc(tid * 16 + i * 8192, R, C); const int Rb = Epi::PERM ? ((R & ~31) + perm32(R & 31)) : R;
        voffA[i] = (unsigned)(R * K + C) * 2u; voffB[i] = (unsigned)(Rb * K + C) * 2u; }
    const size_t kstep = (size_t)(BK * 2);
    const size_t hstep = (size_t)HALF * K * 2;
    const size_t tstep = 2 * hstep;
    const unsigned ldsw = (unsigned)wid * 1024u;
    const int aoff = lds_byte(wr * 64 + fr, fq * 8), boff = lds_byte(wc * 32 + fr, fq * 8);
#define PG8_SA(b, h) (((b) * 2 + (h)) * HTB)
#define PG8_SB(b, h) ((4 + (b) * 2 + (h)) * HTB)
#define PG8_STAGE(bufoff, gbase, voff) do { _Pragma("unroll") for (int _i = 0; _i < 2; ++_i) \
        __builtin_amdgcn_global_load_lds((const unsigned*)((const char*)(gbase) + (voff)[_i]), (PG8_LAS unsigned*)(lds + (bufoff) + ldsw + _i * 8192), 16, 0, 0); } while (0)
#define PG8_LDA(dst, b, h) do { _Pragma("unroll") for (int m = 0; m < 4; ++m) _Pragma("unroll") for (int k = 0; k < 2; ++k) dst[m][k] = *(const PG8_LAS bf16x8*)(lds + PG8_SA(b, h) + aoff + m * 2048 + k * 1024); } while (0)
#define PG8_LDB(dst, b, h) do { _Pragma("unroll") for (int n = 0; n < 2; ++n) _Pragma("unroll") for (int k = 0; k < 2; ++k) dst[n][k] = *(const PG8_LAS bf16x8*)(lds + PG8_SB(b, h) + boff + n * 2048 + k * 1024); } while (0)
#define PG8_MMA(ai, bj, At, Bt) do { __builtin_amdgcn_s_setprio(1); _Pragma("unroll") for (int m = 0; m < 4; ++m) _Pragma("unroll") for (int n = 0; n < 2; ++n) _Pragma("unroll") for (int k = 0; k < 2; ++k) \
        acc[ai][bj][m][n] = __builtin_amdgcn_mfma_f32_16x16x32_bf16(Bt[n][k], At[m][k], acc[ai][bj][m][n], 0, 0, 0); __builtin_amdgcn_s_setprio(0); } while (0)
#define PG8_WAIT_V(n) asm volatile("s_waitcnt vmcnt(" #n ")" ::: "memory")
#define PG8_WAIT_L(n) asm volatile("s_waitcnt lgkmcnt(" #n ")" ::: "memory")
#define PG8_BAR __builtin_amdgcn_s_barrier()
#define PG8_SCHED __builtin_amdgcn_sched_barrier(0)
    Unit cur, nxt; int ui = 0;
    if (!S.next(0, cur)) return;
    f32x4 acc[2][2][4][2];
#pragma unroll
    for (int a = 0; a < 2; ++a)
#pragma unroll
        for (int b = 0; b < 2; ++b)
#pragma unroll
            for (int m = 0; m < 4; ++m)
#pragma unroll
                for (int n = 0; n < 2; ++n) acc[a][b][m][n] = (f32x4){0.f, 0.f, 0.f, 0.f};
    bf16x8 At[4][2], B0[2][2], B1[2][2];
    const char* cA = (const char*)g.A + (size_t)cur.pm * tstep; const char* cB = (const char*)g.Bt + (size_t)cur.pn * tstep;
    S.a_ready(cur);
    if constexpr (SP2) {
        PG8_STAGE(PG8_SB(0, 0), cB, voffB); PG8_STAGE(PG8_SB(0, 1), cB + hstep, voffB); PG8_STAGE(PG8_SA(0, 0), cA, voffA); PG8_STAGE(PG8_SA(0, 1), cA + hstep, voffA);
        if (wr == 1) PG8_BAR;
        PG8_WAIT_V(2); PG8_BAR;
        PG8_STAGE(PG8_SB(1, 0), cB + kstep, voffB); PG8_STAGE(PG8_SA(1, 0), cA + kstep, voffA); PG8_STAGE(PG8_SB(1, 1), cB + hstep + kstep, voffB);
        PG8_WAIT_V(6); PG8_BAR;
    } else {
        PG8_STAGE(PG8_SB(0, 0), cB, voffB); PG8_STAGE(PG8_SA(0, 0), cA, voffA); PG8_STAGE(PG8_SB(0, 1), cB + hstep, voffB); PG8_STAGE(PG8_SA(0, 1), cA + hstep, voffA);
        if (wr == 1) PG8_BAR;
        PG8_WAIT_V(4); PG8_BAR;
        PG8_STAGE(PG8_SB(1, 0), cB + kstep, voffB); PG8_STAGE(PG8_SA(1, 0), cA + kstep, voffA); PG8_STAGE(PG8_SB(1, 1), cB + hstep + kstep, voffB);
        PG8_WAIT_V(6); PG8_BAR;
    }
    for (;;) {
        const bool has_next = S.next(ui + 1, nxt);
        const char* nA = has_next ? (const char*)g.A + (size_t)nxt.pm * tstep : cA; const char* nB = has_next ? (const char*)g.Bt + (size_t)nxt.pn * tstep : cB;
        for (int t = 0; t < nt; t += 2) {
            const bool last = (t == nt - 2);
            const char* a1 = cA + (size_t)(t + 1) * kstep;
            const char* a2 = last ? nA : cA + (size_t)(t + 2) * kstep; const char* b2 = last ? nB : cB + (size_t)(t + 2) * kstep;
            const char* a3 = a2 + kstep; const char* b3 = b2 + kstep;
            if (last && has_next) S.a_ready(nxt);
            if constexpr (SP2) {
            PG8_LDB(B0, 0, 0); PG8_LDB(B1, 0, 1); PG8_SCHED; PG8_LDA(At, 0, 0); PG8_STAGE(PG8_SA(1, 1), a1 + hstep, voffA);
            PG8_WAIT_V(8); PG8_WAIT_L(0); PG8_BAR; PG8_MMA(0, 0, At, B0); PG8_MMA(0, 1, At, B1); PG8_BAR; PG8_SCHED;
            PG8_LDA(At, 0, 1); PG8_STAGE(PG8_SB(0, 0), b2, voffB); PG8_STAGE(PG8_SB(0, 1), b2 + hstep, voffB); PG8_STAGE(PG8_SA(0, 0), a2, voffA);
            PG8_WAIT_V(8); PG8_WAIT_L(0); PG8_BAR; PG8_MMA(1, 0, At, B0); PG8_MMA(1, 1, At, B1); PG8_BAR; PG8_SCHED;
            PG8_LDB(B0, 1, 0); PG8_LDB(B1, 1, 1); PG8_SCHED; PG8_LDA(At, 1, 0); PG8_STAGE(PG8_SA(0, 1), a2 + hstep, voffA);
            PG8_WAIT_V(8); PG8_WAIT_L(0); PG8_BAR; PG8_MMA(0, 0, At, B0); PG8_MMA(0, 1, At, B1); PG8_BAR; PG8_SCHED;
            PG8_LDA(At, 1, 1); PG8_STAGE(PG8_SB(1, 0), b3, voffB); PG8_STAGE(PG8_SB(1, 1), b3 + hstep, voffB); PG8_STAGE(PG8_SA(1, 0), a3, voffA);
            PG8_WAIT_V(8); PG8_WAIT_L(0); PG8_BAR; PG8_MMA(1, 0, At, B0); PG8_MMA(1, 1, At, B1); PG8_BAR; PG8_SCHED;
            } else {
            PG8_LDB(B0, 0, 0); PG8_SCHED; PG8_LDA(At, 0, 0); PG8_STAGE(PG8_SA(1, 1), a1 + hstep, voffA);
            PG8_WAIT_L(8); PG8_BAR; PG8_WAIT_L(0); PG8_MMA(0, 0, At, B0); PG8_BAR; PG8_SCHED;
            PG8_LDB(B1, 0, 1); PG8_STAGE(PG8_SB(0, 0), b2, voffB);
            PG8_BAR; PG8_WAIT_L(0); PG8_MMA(0, 1, At, B1); PG8_BAR;
            PG8_LDA(At, 0, 1); PG8_STAGE(PG8_SA(0, 0), a2, voffA);
            PG8_BAR; PG8_WAIT_L(0); PG8_MMA(1, 0, At, B0); PG8_BAR; PG8_SCHED;
            PG8_STAGE(PG8_SB(0, 1), b2 + hstep, voffB);
            PG8_WAIT_V(6); PG8_BAR; PG8_MMA(1, 1, At, B1); PG8_BAR;
            PG8_LDB(B0, 1, 0); PG8_SCHED; PG8_LDA(At, 1, 0); PG8_STAGE(PG8_SA(0, 1), a2 + hstep, voffA);
            PG8_WAIT_L(8); PG8_BAR; PG8_WAIT_L(0); PG8_MMA(0, 0, At, B0); PG8_BAR; PG8_SCHED;
            PG8_LDB(B1, 1, 1); PG8_STAGE(PG8_SB(1, 0), b3, voffB);
            PG8_BAR; PG8_WAIT_L(0); PG8_MMA(0, 1, At, B1); PG8_BAR;
            PG8_LDA(At, 1, 1); PG8_STAGE(PG8_SA(1, 0), a3, voffA);
            PG8_BAR; PG8_WAIT_L(0); PG8_MMA(1, 0, At, B0); PG8_BAR; PG8_SCHED;
            PG8_STAGE(PG8_SB(1, 1), b3 + hstep, voffB);
            PG8_WAIT_V(6); PG8_BAR; PG8_MMA(1, 1, At, B1); PG8_BAR;
            }
        }
        if constexpr (ALIGN_EPI) { if (wr == 0) PG8_BAR; }
        if constexpr (!Epi::AFTER_DRAIN) { E(acc, cur, wr, wc, fr, fq); S.done(cur); }
        if (!has_next) break;
#pragma unroll
        for (int a = 0; a < 2; ++a)
#pragma unroll
            for (int b = 0; b < 2; ++b)
#pragma unroll
                for (int m = 0; m < 4; ++m)
#pragma unroll
                    for (int n = 0; n < 2; ++n) acc[a][b][m][n] = (f32x4){0.f, 0.f, 0.f, 0.f};
        cur = nxt; cA = nA; cB = nB; ++ui;
        if constexpr (ALIGN_EPI) { if (wr == 1) PG8_BAR; }
    }
    PG8_WAIT_V(0);
    if constexpr (!ALIGN_EPI) { if (wr == 0) PG8_BAR; }
    PG8_BAR;
    if constexpr (Epi::AFTER_DRAIN) { E.fused(acc, cur, wr, wc, fr, fq, lds, wid, lane); S.done(cur); }
#undef PG8_SA
#undef PG8_SB
#undef PG8_STAGE
#undef PG8_LDA
#undef PG8_LDB
#undef PG8_MMA
#undef PG8_WAIT_V
#undef PG8_WAIT_L
#undef PG8_BAR
#undef PG8_SCHED
}
}
#define GAS __attribute__((address_space(1)))
#define LAS __attribute__((address_space(3)))
typedef unsigned short bf16;
typedef unsigned v4u __attribute__((ext_vector_type(4)));
typedef float f32x4 __attribute__((ext_vector_type(4)));
typedef short bf16x8 __attribute__((ext_vector_type(8)));
typedef GAS unsigned gu32;
typedef GAS unsigned long long gu64;
#define RLX_AGENT __ATOMIC_RELAXED, __HIP_MEMORY_SCOPE_AGENT
#define LDS_WAIT() asm volatile("s_waitcnt lgkmcnt(0)" ::: "memory")
#define VM_WAIT() asm volatile("s_waitcnt vmcnt(0)" ::: "memory")
__device__ __forceinline__ unsigned long long rt() { return __builtin_amdgcn_s_memrealtime(); }
__device__ __forceinline__ unsigned f2bf(float f) { unsigned u = __builtin_bit_cast(unsigned, f); return (u + 0x7fffu + ((u >> 16) & 1u)) >> 16; }
__device__ __forceinline__ unsigned pk2(float lo, float hi) { return f2bf(lo) | (f2bf(hi) << 16); }

#define XB_TMO      128
#define XB_XCNT(j)  (256  + 64 * (j))
#define XB_XSUB(j)  (1280 + 64 * (j))
#define XB_XGEN(j)  (2304 + 64 * (j))
#define XB_TOP      3328
#define XB_TOPGEN   3392
#define XCD_BAR_WORDS 3456
#define XB_SPIN_CAP (1u << 21)

__device__ __forceinline__ unsigned xb_ld(unsigned* p)              { return __hip_atomic_load(p, __ATOMIC_RELAXED, __HIP_MEMORY_SCOPE_AGENT); }
__device__ __forceinline__ unsigned xb_add(unsigned* p, unsigned v) { return __hip_atomic_fetch_add(p, v, __ATOMIC_RELAXED, __HIP_MEMORY_SCOPE_AGENT); }
__device__ __forceinline__ unsigned xb_xcc_id() { return (unsigned)__builtin_amdgcn_s_getreg((3 << 11) | 20) & 0xFu; }
#define XB_SPIN(cond, bar) do { unsigned _sp = 0; while (cond) { __builtin_amdgcn_s_sleep(1); \
    if ((++_sp & 255u) == 0u) { if (xb_ld(&(bar)[XB_TMO])) break; if (_sp > XB_SPIN_CAP) { atomicAdd(&(bar)[XB_TMO], 1u); break; } } } } while (0)

struct XcdBarrier {
    unsigned* bar; unsigned x;
    volatile LAS unsigned* st;
};

__device__ __forceinline__ XcdBarrier xcd_barrier_post(unsigned* bar, volatile LAS unsigned* st) {
    XcdBarrier b; b.bar = bar; b.x = xb_xcc_id(); b.st = st;
    if (threadIdx.x == 0) (void)xb_add(&bar[XB_XCNT(b.x)], 1u);
    return b;
}
__device__ __forceinline__ void xcd_barrier_complete(unsigned* bar, unsigned x, unsigned& nloc, unsigned& nx) {
    const unsigned G = gridDim.x * gridDim.y * gridDim.z;
    unsigned sum, cnt, mine, sp = 0u;
    for (;;) {
        sum = 0u; cnt = 0u; mine = 0u;
#pragma unroll
        for (unsigned j = 0; j < 16; ++j) { const unsigned c = xb_ld(&bar[XB_XCNT(j)]); sum += c; cnt += (c > 0u) ? 1u : 0u; mine = (j == x) ? c : mine; }
        if (sum == G) break;
        __builtin_amdgcn_s_sleep(1);
        if ((++sp & 255u) == 0u) { if (xb_ld(&bar[XB_TMO])) break; if (sp > XB_SPIN_CAP) { atomicAdd(&bar[XB_TMO], 1u); break; } }
    }
    nloc = mine > 0u ? mine : 1u; nx = cnt > 0u ? cnt : 1u;
}

__device__ __forceinline__ void xcd_barrier(const XcdBarrier& b) {
    asm volatile("s_waitcnt vmcnt(0)" ::: "memory");
    __syncthreads();
    if (threadIdx.x == 0) {
        unsigned* bar = b.bar;
        __builtin_amdgcn_s_waitcnt(0);
        unsigned nloc = b.st[0], nx = b.st[1];
        if (nloc == 0u) { xcd_barrier_complete(bar, b.x, nloc, nx); b.st[0] = nloc; b.st[1] = nx; }
        const unsigned old = xb_add(&bar[XB_XSUB(b.x)], 1u);
        const unsigned gen = old / nloc;
        if (old + 1u == (gen + 1u) * nloc) {
            __builtin_amdgcn_fence(__ATOMIC_RELEASE, "agent");
            asm volatile("s_waitcnt vmcnt(0)" ::: "memory");
            const unsigned og = xb_add(&bar[XB_TOP], 1u);
            const unsigned tg = og / nx;
            if (og + 1u == (tg + 1u) * nx) xb_add(&bar[XB_TOPGEN], 1u);
            else XB_SPIN(xb_ld(&bar[XB_TOPGEN]) == tg, bar);
            __builtin_amdgcn_fence(__ATOMIC_ACQUIRE, "agent");
            xb_add(&bar[XB_XGEN(b.x)], 1u);
            asm volatile("s_waitcnt vmcnt(0)" ::: "memory");
        } else {
            XB_SPIN(xb_ld(&bar[XB_XGEN(b.x)]) == gen, bar);
            __builtin_amdgcn_fence(__ATOMIC_ACQUIRE, "agent");
            asm volatile("s_waitcnt vmcnt(0)" ::: "memory");
        }
    }
    __syncthreads();
}

constexpr int NWAVES = 8;
constexpr int BATCH = 8, SEQ = 4096, D = 1024, M = BATCH * SEQ;
constexpr int DIN = 2048, CONVW = 512, SGWD = 512, NHEAD = 8, CKER = 31, CHUNK = 128;
constexpr int PHEADS = 8, TOPK = 16, NKEYS = 128, NEXP = 16384, PLE = 256, NSEL = PHEADS * TOPK;
constexpr float ALPHA = 1.18920711500272f;
constexpr float LN_EPS = 1e-5f;

constexpr size_t MiB = 1u << 20;
constexpr size_t WS_CTL = 0, CTL_ZERO_BYTES = 1 * MiB;
constexpr size_t WS_WIN = 2 * MiB, WS_WO = 6 * MiB, WS_WQ = 8 * MiB, WS_WG = 12 * MiB, WS_WP = 14 * MiB, WS_KEYS = 14 * MiB + 512 * 1024, WS_SGW = 15 * MiB, WS_BINP = 15 * MiB + 512 * 1024;
constexpr size_t WS_UT = 16 * MiB, WS_VT = 32 * MiB, WS_SC = 48 * MiB;
constexpr size_t WS_XN = 96 * MiB, WS_H1 = WS_XN;
constexpr size_t WS_PB = 160 * MiB;
constexpr size_t WS_CB = 176 * MiB, WS_GU = 208 * MiB, WS_VN = 240 * MiB;
constexpr size_t WS_PP = 176 * MiB, WS_IDX = 240 * MiB, WS_GW = 256 * MiB;
constexpr size_t WS_MIX = 272 * MiB, WS_GP = WS_MIX;
constexpr size_t WS_Z = 336 * MiB, WS_MIXO = WS_Z, WS_Q = WS_Z;
constexpr size_t WS_END = 464 * MiB;
constexpr int CW_BAR = 4096;

constexpr int RING_OFF = 0, RING_BYTES = 131072;
constexpr int LDSCTL_OFF = RING_BYTES, MISC_OFF = LDSCTL_OFF + 320;
constexpr int LDS_BYTES = 147456;

__device__ __forceinline__ float bf_lo(unsigned u) { return __uint_as_float(u << 16); }
__device__ __forceinline__ float bf_hi(unsigned u) { return __uint_as_float(u & 0xffff0000u); }
__device__ __forceinline__ float wave_sum(float v) {
#pragma unroll
    for (int o = 1; o < 64; o <<= 1) v += __shfl_xor(v, o);
    return v;
}
__device__ __forceinline__ float sigmoidf_(float x) { return 1.f / (1.f + __expf(-x)); }
__device__ __forceinline__ float gelu_exact(float x) { return 0.5f * x * (1.f + erff(x * 0.70710678118654752f)); }

__host__ __device__ __forceinline__ int win_src(int np) {
    const int j = np >> 8, lc = np & 255;
    if (j < 4) return (lc < 128) ? (128 * j + lc) : (512 + 128 * j + (lc - 128));
    const int jj = j - 4, base = (jj < 2) ? 1024 : 1536, head = 4 * (jj & 1) + ((lc >> 5) & 3), ch = 32 * (lc >> 7) + (lc & 31);
    return base + head * 64 + ch;
}

template <bool PERMW>
__device__ __forceinline__ void p0_transpose_item(const float* W, int K, int N, bf16* WT, LAS float* scr, int item, int lane) {
    const int nblk = N / 32, kb = item / nblk, nb = item % nblk, k0 = 64 * kb, n0d = 32 * nb, n0s = PERMW ? win_src(n0d) : n0d;
#pragma unroll 8
    for (int i = 0; i < 32; ++i) { const int kk = 2 * i + (lane >> 5); scr[kk * 33 + (lane & 31)] = W[(size_t)(k0 + kk) * N + n0s + (lane & 31)]; }
    LDS_WAIT(); asm volatile("" ::: "memory");
    const int c = lane & 7;
#pragma unroll
    for (int j = 0; j < 4; ++j) { const int n = (lane >> 3) + 8 * j; const LAS float* s = scr + (8 * c) * 33 + n;
        v4u o; o.x = pk2(s[0 * 33], s[1 * 33]); o.y = pk2(s[2 * 33], s[3 * 33]); o.z = pk2(s[4 * 33], s[5 * 33]); o.w = pk2(s[6 * 33], s[7 * 33]);
        *(GAS v4u*)(WT + (size_t)(n0d + n) * K + k0 + 8 * c) = o; }
    LDS_WAIT(); asm volatile("" ::: "memory");
}

typedef unsigned u32x2 __attribute__((ext_vector_type(2)));
typedef float f32x16 __attribute__((ext_vector_type(16)));

__device__ __forceinline__ void cvt_f32_bf16(const float* src, bf16* dst, size_t n4, size_t gtid, size_t nthr) {
    for (size_t i = gtid; i < n4; i += nthr) { const f32x4 v = ((const f32x4*)src)[i]; u32x2 o; o.x = pk2(v.x, v.y); o.y = pk2(v.z, v.w); ((u32x2*)dst)[i] = o; }
}

__device__ __forceinline__ void ln16(f32x4 (&v)[4], const float* g, const float* b, int lane) {
    float s = 0.f;
#pragma unroll
    for (int j = 0; j < 4; ++j) s += (v[j].x + v[j].y) + (v[j].z + v[j].w);
    const float mean = wave_sum(s) * (1.f / D); float s2 = 0.f;
#pragma unroll
    for (int j = 0; j < 4; ++j) { v[j] = v[j] - mean; s2 += (v[j].x * v[j].x + v[j].y * v[j].y) + (v[j].z * v[j].z + v[j].w * v[j].w); }
    const float rstd = 1.f / sqrtf(wave_sum(s2) * (1.f / D) + LN_EPS);
#pragma unroll
    for (int j = 0; j < 4; ++j) { const f32x4 gg = ((const f32x4*)g)[lane + 64 * j], bb = ((const f32x4*)b)[lane + 64 * j]; v[j] = v[j] * rstd * gg + bb; }
}
__device__ __forceinline__ void store_bf16_row16(bf16* orow, const f32x4 (&v)[4], int lane) {
#pragma unroll
    for (int j = 0; j < 4; ++j) { u32x2 o; o.x = pk2(v[j].x, v[j].y); o.y = pk2(v[j].z, v[j].w); ((u32x2*)orow)[lane + 64 * j] = o; }
}
__device__ __forceinline__ void load_bf16_row16(const bf16* row, f32x4 (&v)[4], int lane) {
#pragma unroll
    for (int j = 0; j < 4; ++j) { const u32x2 u = ((const u32x2*)row)[lane + 64 * j]; v[j] = (f32x4){bf_lo(u.x), bf_hi(u.x), bf_lo(u.y), bf_hi(u.y)}; }
}
__device__ __forceinline__ void unpack8(const v4u u, float (&f)[8]) {
    f[0] = bf_lo(u.x); f[1] = bf_hi(u.x); f[2] = bf_lo(u.y); f[3] = bf_hi(u.y); f[4] = bf_lo(u.z); f[5] = bf_hi(u.z); f[6] = bf_lo(u.w); f[7] = bf_hi(u.w);
}
__device__ __forceinline__ v4u pack8(const float (&f)[8]) { v4u o; o.x = pk2(f[0], f[1]); o.y = pk2(f[2], f[3]); o.z = pk2(f[4], f[5]); o.w = pk2(f[6], f[7]); return o; }


__device__ __forceinline__ int f2key(float f) { const int b = __float_as_int(f); return b ^ ((b >> 31) & 0x7fffffff); }
__device__ __forceinline__ float key2f(int k) { return __int_as_float(k ^ ((k >> 31) & 0x7fffffff)); }
#define CE_DESC(a, b) do { const int _mx = max((a), (b)), _mn = min((a), (b)); (a) = _mx; (b) = _mn; } while (0)
__device__ __forceinline__ void sort16_desc(int (&a)[16]) {
#pragma unroll
    for (int k = 2; k <= 16; k <<= 1)
#pragma unroll
        for (int j = k >> 1; j > 0; j >>= 1)
#pragma unroll
            for (int i = 0; i < 16; ++i) { const int l = i ^ j; if (l > i) { if ((i & k) == 0) CE_DESC(a[i], a[l]); else CE_DESC(a[l], a[i]); } }
}
__device__ __forceinline__ void merge16_desc(int (&a)[16], const int (&b)[16]) {
#pragma unroll
    for (int i = 0; i < 16; ++i) a[i] = max(a[i], b[15 - i]);
#pragma unroll
    for (int j = 8; j > 0; j >>= 1)
#pragma unroll
        for (int i = 0; i < 16; ++i) { const int l = i ^ j; if (l > i) CE_DESC(a[i], a[l]); }
}

typedef __bf16 bf16x2_t __attribute__((ext_vector_type(2)));
__device__ __forceinline__ float dot2bf(unsigned w, unsigned x, float acc) { return __builtin_amdgcn_fdot2_f32_bf16(__builtin_bit_cast(bf16x2_t, w), __builtin_bit_cast(bf16x2_t, x), acc, false); }
__device__ __forceinline__ void sort128_asc(unsigned& k0, unsigned& k1, int lane) {
#pragma unroll
    for (int k = 2; k <= 128; k <<= 1) {
#pragma unroll
        for (int j = k >> 1; j > 0; j >>= 1) {
            if (j == 64) { const unsigned a = min(k0, k1), b = max(k0, k1); k0 = a; k1 = b; }
            else {
                const bool asc = (k == 128) ? true : ((lane & k) == 0);
                const bool keep_min = (((lane & j) == 0) == asc);
                const unsigned p0 = (unsigned)__shfl_xor((int)k0, j), p1 = (unsigned)__shfl_xor((int)k1, j);
                k0 = keep_min ? min(k0, p0) : max(k0, p0); k1 = keep_min ? min(k1, p1) : max(k1, p1);
            }
        }
    }
}

typedef float f32x2v __attribute__((ext_vector_type(2)));
__device__ __forceinline__ float swapadd32(float a, float b) { auto r = __builtin_amdgcn_permlane32_swap(__float_as_uint(a), __float_as_uint(b), false, false); const unsigned r0 = r[0], r1 = r[1]; return __uint_as_float(r0) + __uint_as_float(r1); }
__device__ __forceinline__ float swapadd16(float a, float b) { auto r = __builtin_amdgcn_permlane16_swap(__float_as_uint(a), __float_as_uint(b), false, false); const unsigned r0 = r[0], r1 = r[1]; return __uint_as_float(r0) + __uint_as_float(r1); }
template <int CTRL> __device__ __forceinline__ float dpp_get(float v) { return __builtin_bit_cast(float, __builtin_amdgcn_update_dpp(0, __builtin_bit_cast(int, v), CTRL, 0xf, 0xf, true)); }
__device__ __forceinline__ float reduce8(const float (&d)[8], int lane) {
    const float e0 = swapadd32(d[0], d[4]), e1 = swapadd32(d[1], d[5]), e2 = swapadd32(d[2], d[6]), e3 = swapadd32(d[3], d[7]);
    const float f0 = swapadd16(e0, e2), f1 = swapadd16(e1, e3);
    const bool b3 = (lane & 8) != 0;
    const float keep = b3 ? f1 : f0, send = b3 ? f0 : f1;
    float g = keep + dpp_get<0x140>(send);
    g += dpp_get<0x141>(g);
    g += dpp_get<0x4e>(g);
    g += dpp_get<0xb1>(g);
    return g;
}
__device__ __forceinline__ float gelu_as(float v) {
    const float av = fabsf(v), t = __builtin_amdgcn_rcpf(av * 0.2316418882f + 1.0f);
    float q = t * 0.5307027145f + (-0.7265760135f); q = q * t + 0.7107068705f; q = q * t + (-0.142248368f); q = q * t + 0.127414796f; q = q * t;
    const float e = __builtin_amdgcn_exp2f((v * v) * (-0.72134752044f));
    const float m = v * (q * e);
    return v < 0.f ? m : v - m;
}
__device__ __forceinline__ void fp8x16_to_f32(const v4u w, float (&f)[16]) {
    const unsigned ww[4] = {w.x, w.y, w.z, w.w};
#pragma unroll
    for (int j = 0; j < 4; ++j) { const f32x2v lo = __builtin_amdgcn_cvt_pk_f32_fp8((int)ww[j], false), hi = __builtin_amdgcn_cvt_pk_f32_fp8((int)ww[j], true);
        f[4 * j] = lo.x; f[4 * j + 1] = lo.y; f[4 * j + 2] = hi.x; f[4 * j + 3] = hi.y; }
}

__device__ __forceinline__ void sort512_asc(unsigned (&v)[8], int lane) {
#pragma unroll
    for (int k = 2; k <= 512; k <<= 1) {
#pragma unroll
        for (int j = k >> 1; j > 0; j >>= 1) {
            if (j >= 64) {
                const int dr = j >> 6;
#pragma unroll
                for (int r = 0; r < 8; ++r) if ((r & dr) == 0) {
                    const bool asc = (k == 512) ? true : (((r << 6) & k) == 0);
                    const unsigned a = min(v[r], v[r | dr]), b = max(v[r], v[r | dr]);
                    v[r] = asc ? a : b; v[r | dr] = asc ? b : a; }
            } else {
                const bool lower = (lane & j) == 0;
#pragma unroll
                for (int r = 0; r < 8; ++r) {
                    const bool asc = (k == 512) ? true : ((k >= 64) ? (((r << 6) & k) == 0) : ((lane & k) == 0));
                    const unsigned pv = (unsigned)__shfl_xor((int)v[r], j);
                    v[r] = (lower == asc) ? min(v[r], pv) : max(v[r], pv); }
            }
        }
    }
}
__device__ __forceinline__ float reduce4(float d0, float d1, float d2, float d3) {
    const float e0 = swapadd32(d0, d2), e1 = swapadd32(d1, d3);
    float g = swapadd16(e0, e1);
    g += dpp_get<0x140>(g); g += dpp_get<0x141>(g); g += dpp_get<0x4e>(g); g += dpp_get<0xb1>(g);
    return g;
}
__device__ __forceinline__ float dot16_fp8_bf(const v4u w, const v4u ha, const v4u hb) {
    const unsigned ww[4] = {w.x, w.y, w.z, w.w}; const unsigned hh[8] = {ha.x, ha.y, ha.z, ha.w, hb.x, hb.y, hb.z, hb.w}; float s0 = 0.f, s1 = 0.f;
#pragma unroll
    for (int j = 0; j < 4; ++j) { const f32x2v lo = __builtin_amdgcn_cvt_pk_f32_fp8((int)ww[j], false), hi = __builtin_amdgcn_cvt_pk_f32_fp8((int)ww[j], true);
        const unsigned b0 = __builtin_amdgcn_perm(__float_as_uint(lo.y), __float_as_uint(lo.x), 0x07060302u), b1 = __builtin_amdgcn_perm(__float_as_uint(hi.y), __float_as_uint(hi.x), 0x07060302u);
        s0 = dot2bf(b0, hh[2 * j], s0); s1 = dot2bf(b1, hh[2 * j + 1], s1); }
    return s0 + s1;
}
__device__ __forceinline__ float dot16_fp8_bf2(const v4u w, const v4u ha, const v4u hb) {
    const unsigned ww[4] = {w.x, w.y, w.z, w.w}; const unsigned hh[8] = {ha.x, ha.y, ha.z, ha.w, hb.x, hb.y, hb.z, hb.w}; float s0 = 0.f, s1 = 0.f;
#pragma unroll
    for (int j = 0; j < 4; ++j) { const bf16x2_t lo = __builtin_amdgcn_cvt_scalef32_pk_bf16_fp8(ww[j], 1.0f, false), hi = __builtin_amdgcn_cvt_scalef32_pk_bf16_fp8(ww[j], 1.0f, true);
        s0 = __builtin_amdgcn_fdot2_f32_bf16(lo, __builtin_bit_cast(bf16x2_t, hh[2 * j]), s0, false); s1 = __builtin_amdgcn_fdot2_f32_bf16(hi, __builtin_bit_cast(bf16x2_t, hh[2 * j + 1]), s1, false); }
    return s0 + s1;
}
__device__ __forceinline__ float dot16_fp8(const v4u w, const float (&h)[16]) {
    const unsigned ww[4] = {w.x, w.y, w.z, w.w}; float s0 = 0.f, s1 = 0.f;
#pragma unroll
    for (int j = 0; j < 4; ++j) { const f32x2v lo = __builtin_amdgcn_cvt_pk_f32_fp8((int)ww[j], false), hi = __builtin_amdgcn_cvt_pk_f32_fp8((int)ww[j], true);
        s0 = __builtin_fmaf(lo.x, h[4 * j], s0); s1 = __builtin_fmaf(lo.y, h[4 * j + 1], s1); s0 = __builtin_fmaf(hi.x, h[4 * j + 2], s0); s1 = __builtin_fmaf(hi.y, h[4 * j + 3], s1); }
    return s0 + s1;
}

struct Args { const float* in[27]; float* out; unsigned char* ws; };

__global__ void __launch_bounds__(NWAVES * 64, 2) fwd_kernel(Args args) {
    extern __shared__ __attribute__((aligned(16))) unsigned char lds_raw[];
    LAS unsigned char* lds = (LAS unsigned char*)lds_raw;
    volatile LAS unsigned* MISC = (volatile LAS unsigned*)(lds + MISC_OFF);
    const int tid = threadIdx.x, lane = tid & 63, wave = __builtin_amdgcn_readfirstlane(tid >> 6);
    const int G = gridDim.x; const int bx = blockIdx.x; const int vcu = (G % 8 == 0) ? (bx % 8) * (G / 8) + bx / 8 : bx;
    const int gw = vcu * NWAVES + wave, NGW = G * NWAVES;
    const size_t gtid = (size_t)gw * 64 + lane, nthr = (size_t)NGW * 64;
    unsigned char* ws = args.ws;
    gu32* ctl = (gu32*)(ws + WS_CTL);
    for (int u = tid; u < (LDS_BYTES - LDSCTL_OFF) / 4; u += NWAVES * 64) ((LAS unsigned*)(lds + LDSCTL_OFF))[u] = 0u;
    __syncthreads();
    XcdBarrier bar = xcd_barrier_post((unsigned*)(ctl + CW_BAR), MISC + 8);
#define GRID_BAR() xcd_barrier(bar)

    const float* x = args.in[0]; const float* p_in = args.in[1];
    const float *ln0_g = args.in[2], *ln0_b = args.in[3], *w_in = args.in[4], *b_in = args.in[5], *conv_w = args.in[6], *conv_b = args.in[7], *gn_g = args.in[8], *gn_b = args.in[9];
    const float *sg_ln_g = args.in[10], *sg_ln_b = args.in[11], *sg_w = args.in[12], *sg_b = args.in[13], *w_o = args.in[14], *b_o = args.in[15], *ln1_g = args.in[16], *ln1_b = args.in[17];
    const float *peer_wq = args.in[18], *peer_keys = args.in[19], *peer_u = args.in[20], *peer_v = args.in[21], *ple_wp = args.in[22], *ple_wg = args.in[23], *ple_bg = args.in[24], *ln2_g = args.in[25], *ln2_b = args.in[26];
    bf16 *WIN = (bf16*)(ws + WS_WIN), *WO = (bf16*)(ws + WS_WO), *WQ = (bf16*)(ws + WS_WQ), *WG = (bf16*)(ws + WS_WG), *WP = (bf16*)(ws + WS_WP), *KEYS = (bf16*)(ws + WS_KEYS), *SGW = (bf16*)(ws + WS_SGW);
    float* BINP = (float*)(ws + WS_BINP);
    unsigned char *U8 = ws + WS_UT, *V8 = ws + WS_VT; float* SC = (float*)(ws + WS_SC);
    bf16 *XN = (bf16*)(ws + WS_XN), *H1 = (bf16*)(ws + WS_H1), *PB = (bf16*)(ws + WS_PB);
    bf16 *CB = (bf16*)(ws + WS_CB), *GU = (bf16*)(ws + WS_GU), *VN = (bf16*)(ws + WS_VN), *PP = (bf16*)(ws + WS_PP), *MIX = (bf16*)(ws + WS_MIX), *GP = (bf16*)(ws + WS_GP);
    bf16 *Z = (bf16*)(ws + WS_Z), *MIXO = (bf16*)(ws + WS_MIXO), *Q = (bf16*)(ws + WS_Q);
    unsigned* PK = (unsigned*)(ws + WS_IDX);

    {
        LAS float* scr = (LAS float*)(lds + RING_OFF + wave * 16384);
        constexpr int I_IN = (D / 64) * (DIN / 32), I_O = (D / 64) * (D / 32), I_Q = (D / 64) * (2048 / 32), I_G = I_O, I_P = (PLE / 64) * (D / 32);
        constexpr int NITEMS = I_IN + I_O + I_Q + I_G + I_P;
        for (int it = gw; it < NITEMS; it += NGW) {
            int r = it;
            if (r < I_IN) { p0_transpose_item<true>(w_in, D, DIN, WIN, scr, r, lane); continue; } r -= I_IN;
            if (r < I_O) { p0_transpose_item<false>(w_o, D, D, WO, scr, r, lane); continue; } r -= I_O;
            if (r < I_Q) { p0_transpose_item<false>(peer_wq, D, 2048, WQ, scr, r, lane); continue; } r -= I_Q;
            if (r < I_G) { p0_transpose_item<false>(ple_wg, D, D, WG, scr, r, lane); continue; } r -= I_G;
            p0_transpose_item<false>(ple_wp, PLE, D, WP, scr, r, lane);
        }
        for (size_t i = gtid; i < DIN; i += nthr) BINP[i] = b_in[win_src((int)i)];
        cvt_f32_bf16(peer_keys, KEYS, (size_t)PHEADS * 2 * NKEYS * 128 / 4, gtid, nthr);
        for (int r = gw; r < 2 * NEXP; r += NGW) {
            const bool isv = r >= NEXP; const int e = isv ? r - NEXP : r;
            const f32x4* srcp = (const f32x4*)((isv ? peer_v : peer_u) + (size_t)e * D + 16 * lane);
            f32x4 xv[4]; float mx = 0.f;
#pragma unroll
            for (int j = 0; j < 4; ++j) { xv[j] = srcp[j]; mx = fmaxf(fmaxf(mx, fmaxf(fabsf(xv[j].x), fabsf(xv[j].y))), fmaxf(fabsf(xv[j].z), fabsf(xv[j].w))); }
#pragma unroll
            for (int o = 1; o < 64; o <<= 1) mx = fmaxf(mx, __shfl_xor(mx, o));
            mx = fmaxf(mx, 1e-30f); const float sc = 416.f / mx;
            v4u o4; unsigned wds[4];
            if (isv) {
#pragma unroll
                for (int j = 0; j < 4; ++j) { int w = __builtin_amdgcn_cvt_pk_fp8_f32(xv[j].x * sc, xv[j].y * sc, 0, false); w = __builtin_amdgcn_cvt_pk_fp8_f32(xv[j].z * sc, xv[j].w * sc, w, true); wds[j] = (unsigned)w; }
            } else {
                const float si = 127.f / mx;
#pragma unroll
                for (int j = 0; j < 4; ++j) wds[j] = ((unsigned)__float2int_rn(xv[j].x * si) & 0xffu) | (((unsigned)__float2int_rn(xv[j].y * si) & 0xffu) << 8) | (((unsigned)__float2int_rn(xv[j].z * si) & 0xffu) << 16) | (((unsigned)__float2int_rn(xv[j].w * si) & 0xffu) << 24);
            }
            o4.x = wds[0]; o4.y = wds[1]; o4.z = wds[2]; o4.w = wds[3];
            *(v4u*)((isv ? V8 : U8) + (size_t)e * D + 16 * lane) = o4;
            if (lane == 0) SC[2 * e + (isv ? 1 : 0)] = isv ? mx * (1.f / 416.f) : mx * (1.f / 127.f);
        }
        cvt_f32_bf16(p_in, PB, (size_t)M * PLE / 4, gtid, nthr);
        for (size_t i = gtid; i < (size_t)NHEAD * CHUNK * CHUNK / 4; i += nthr) {
            const f32x4 v = ((const f32x4*)sg_w)[i]; const int e = (int)(i * 4), t = (e >> 7) & 127, s = e & 127;
            u32x2 o; o.x = pk2(s <= t ? v.x : 0.f, s + 1 <= t ? v.y : 0.f); o.y = pk2(s + 2 <= t ? v.z : 0.f, s + 3 <= t ? v.w : 0.f); ((u32x2*)SGW)[i] = o; }
        for (int m = gw; m < M; m += NGW) {
            f32x4 v[4];
#pragma unroll
            for (int j = 0; j < 4; ++j) v[j] = ((const f32x4*)(x + (size_t)m * D))[lane + 64 * j];
            ln16(v, ln0_g, ln0_b, lane); store_bf16_row16(XN + (size_t)m * D, v, lane);
        }
    }
    GRID_BAR();
    {
        pg8::Gemm g{XN, WIN, M, DIN, D}; pg8::StaticOrder S; S.init(M, DIN, G, bx);
        pg8::EpiBf16<0> E{Z, DIN, BINP, 0, 0, 1.f};
        pg8::gemm_phase<pg8::EpiBf16<0>, pg8::StaticOrder, true, true>(lds + RING_OFF, g, S, E);
    }
    GRID_BAR();
    for (int m = gw; m < M; m += NGW) {
        const bf16* z = Z + (size_t)m * DIN;
        { const int c0 = 8 * lane, j = c0 >> 7, lc = c0 & 127; float a[8], gt[8];
          unpack8(*(const v4u*)(z + 256 * j + lc), a); unpack8(*(const v4u*)(z + 256 * j + 128 + lc), gt);
#pragma unroll
          for (int i = 0; i < 8; ++i) a[i] = a[i] * sigmoidf_(gt[i]);
          *(v4u*)(CB + (size_t)m * CONVW + c0) = pack8(a); }
        { const int h = lane >> 3, ch0 = 8 * (lane & 7), lcs = 128 * (ch0 >> 5) + 32 * (h & 3) + (ch0 & 31); float u[8], v[8];
          unpack8(*(const v4u*)(z + 256 * (4 + (h >> 2)) + lcs), u); unpack8(*(const v4u*)(z + 256 * (6 + (h >> 2)) + lcs), v);
          float s = 0.f;
#pragma unroll
          for (int i = 0; i < 8; ++i) { u[i] = gelu_exact(u[i]); v[i] = gelu_exact(v[i]); s += v[i]; }
          *(v4u*)(GU + (size_t)m * SGWD + h * 64 + ch0) = pack8(u);
          s += __shfl_xor(s, 1); s += __shfl_xor(s, 2); s += __shfl_xor(s, 4);
          const float mean = s * (1.f / 64.f); float q = 0.f;
#pragma unroll
          for (int i = 0; i < 8; ++i) { v[i] -= mean; q += v[i] * v[i]; }
          q += __shfl_xor(q, 1); q += __shfl_xor(q, 2); q += __shfl_xor(q, 4);
          const float rstd = 1.f / sqrtf(q * (1.f / 64.f) + LN_EPS);
#pragma unroll
          for (int i = 0; i < 8; ++i) v[i] = v[i] * rstd * sg_ln_g[h * 64 + ch0 + i] + sg_ln_b[h * 64 + ch0 + i];
          *(v4u*)(VN + (size_t)m * SGWD + h * 64 + ch0) = pack8(v); }
    }
    GRID_BAR();
    for (int m = gw; m < M; m += NGW) {
        const int t = m & (SEQ - 1), c0 = 8 * lane; float acc[8];
#pragma unroll
        for (int i = 0; i < 8; ++i) acc[i] = conv_b[c0 + i];
        for (int j = 0; j < CKER; ++j) { if (t - (CKER - 1) + j < 0) continue;
            float xv[8]; unpack8(*(const v4u*)(CB + (size_t)(m - (CKER - 1) + j) * CONVW + c0), xv);
            const f32x4 w0 = *(const f32x4*)(conv_w + j * CONVW + c0), w1 = *(const f32x4*)(conv_w + j * CONVW + c0 + 4);
            acc[0] += w0.x * xv[0]; acc[1] += w0.y * xv[1]; acc[2] += w0.z * xv[2]; acc[3] += w0.w * xv[3];
            acc[4] += w1.x * xv[4]; acc[5] += w1.y * xv[5]; acc[6] += w1.z * xv[6]; acc[7] += w1.w * xv[7]; }
        float s = 0.f;
#pragma unroll
        for (int i = 0; i < 8; ++i) s += acc[i];
        s += __shfl_xor(s, 1); s += __shfl_xor(s, 2); s += __shfl_xor(s, 4);
        const float mean = s * (1.f / 64.f); float q = 0.f;
#pragma unroll
        for (int i = 0; i < 8; ++i) { acc[i] -= mean; q += acc[i] * acc[i]; }
        q += __shfl_xor(q, 1); q += __shfl_xor(q, 2); q += __shfl_xor(q, 4);
        const float rstd = 1.f / sqrtf(q * (1.f / 64.f) + LN_EPS);
#pragma unroll
        for (int i = 0; i < 8; ++i) { const float y = acc[i] * rstd * gn_g[c0 + i] + gn_b[c0 + i]; acc[i] = y * sigmoidf_(y); }
        *(v4u*)(MIX + (size_t)m * D + c0) = pack8(acc);
    }
    for (int ch = vcu; ch < M / CHUNK; ch += G) {
        const int h = wave, r31 = lane & 31, hh = lane >> 5;
        LAS unsigned char* T = lds + RING_OFF + wave * 16384;
#pragma unroll 4
        for (int i = 0; i < 16; ++i) { const int e = lane + 64 * i, s = e >> 3, dc = e & 7;
            const v4u v = *(const v4u*)(VN + (size_t)(ch * CHUNK + s) * SGWD + h * 64 + dc * 8);
            const unsigned w[4] = {v.x, v.y, v.z, v.w};
#pragma unroll
            for (int k = 0; k < 8; ++k) { const int d = dc * 8 + k; const unsigned short val = (unsigned short)((k & 1) ? (w[k >> 1] >> 16) : (w[k >> 1] & 0xffffu));
                *(LAS unsigned short*)(T + d * 256 + (((s >> 3) ^ (d & 15)) << 4) + (s & 7) * 2) = val; } }
        LDS_WAIT(); asm volatile("" ::: "memory");
        f32x16 acc[2][4];
#pragma unroll
        for (int a = 0; a < 2; ++a)
#pragma unroll
            for (int b = 0; b < 4; ++b)
#pragma unroll
                for (int r = 0; r < 16; ++r) acc[a][b][r] = 0.f;
#pragma unroll 2
        for (int step = 0; step < 8; ++step) {
            bf16x8 A[2], B[4];
#pragma unroll
            for (int dm = 0; dm < 2; ++dm) { const int d = 32 * dm + r31; A[dm] = *(const LAS bf16x8*)(T + d * 256 + (((2 * step + hh) ^ (d & 15)) << 4)); }
#pragma unroll
            for (int tn = 0; tn < 4; ++tn) B[tn] = *(const bf16x8*)(SGW + ((size_t)h * CHUNK + 32 * tn + r31) * CHUNK + 16 * step + 8 * hh);
#pragma unroll
            for (int dm = 0; dm < 2; ++dm)
#pragma unroll
                for (int tn = 0; tn < 4; ++tn) acc[dm][tn] = __builtin_amdgcn_mfma_f32_32x32x16_bf16(A[dm], B[tn], acc[dm][tn], 0, 0, 0);
        }
#pragma unroll
        for (int tn = 0; tn < 4; ++tn) { const int t = 32 * tn + r31; const size_t m = (size_t)ch * CHUNK + t; const float bias = sg_b[h * CHUNK + t];
#pragma unroll
            for (int dm = 0; dm < 2; ++dm)
#pragma unroll
                for (int rq = 0; rq < 4; ++rq) { const int d0 = 32 * dm + 8 * rq + 4 * hh;
                    const u32x2 gu = *(const u32x2*)(GU + m * SGWD + h * 64 + d0);
                    u32x2 o; o.x = pk2(bf_lo(gu.x) * (acc[dm][tn][4 * rq + 0] + bias), bf_hi(gu.x) * (acc[dm][tn][4 * rq + 1] + bias));
                    o.y = pk2(bf_lo(gu.y) * (acc[dm][tn][4 * rq + 2] + bias), bf_hi(gu.y) * (acc[dm][tn][4 * rq + 3] + bias));
                    *(u32x2*)(MIX + m * D + 512 + h * 64 + d0) = o; } }
        LDS_WAIT(); asm volatile("" ::: "memory");
    }
    GRID_BAR();
    {
        pg8::Gemm g{MIX, WO, M, D, D}; pg8::StaticOrder S; S.init(M, D, G, bx);
        pg8::EpiBf16<0> E{MIXO, D, b_o, 0, 0, 1.f};
        pg8::gemm_phase<pg8::EpiBf16<0>, pg8::StaticOrder, true, true>(lds + RING_OFF, g, S, E);
    }
    GRID_BAR();
    for (int m = gw; m < M; m += NGW) {
        f32x4 a[4], b[4]; load_bf16_row16(XN + (size_t)m * D, a, lane); load_bf16_row16(MIXO + (size_t)m * D, b, lane);
#pragma unroll
        for (int j = 0; j < 4; ++j) a[j] = a[j] * ALPHA + b[j];
        ln16(a, ln1_g, ln1_b, lane); store_bf16_row16(H1 + (size_t)m * D, a, lane);
    }
    GRID_BAR();
    {
        { pg8::Gemm g{H1, WQ, M, 2048, D}; pg8::StaticOrder S; S.init(M, 2048, G, bx); pg8::EpiBf16<0> E{Q, 2048, nullptr, 0, 0, 1.f};
          pg8::gemm_phase<pg8::EpiBf16<0>, pg8::StaticOrder, true, true>(lds + RING_OFF, g, S, E); }
        { pg8::Gemm g{H1, WG, M, D, D}; pg8::StaticOrder S; S.init(M, D, G, bx); pg8::EpiBf16<0> E{GP, D, ple_bg, 0, 0, 1.f};
          pg8::gemm_phase<pg8::EpiBf16<0>, pg8::StaticOrder, true, true>(lds + RING_OFF, g, S, E); }
        { pg8::Gemm g{PB, WP, M, D, PLE}; pg8::StaticOrder S; S.init(M, D, G, bx); pg8::EpiBf16<0> E{PP, D, nullptr, 0, 0, 1.f};
          pg8::gemm_phase<pg8::EpiBf16<0>, pg8::StaticOrder, true, true>(lds + RING_OFF, g, S, E); }
    }
    GRID_BAR();
    for (int u = gw; u < (M / 32) * PHEADS; u += NGW) {
        const int tg = u >> 3, h = u & 7, r31 = lane & 31, hh = lane >> 5; const size_t tok = (size_t)tg * 32 + r31;
        int t12[2][16];
#pragma unroll
        for (int half = 0; half < 2; ++half) {
            f32x16 acc[4];
#pragma unroll
            for (int kb = 0; kb < 4; ++kb)
#pragma unroll
                for (int r = 0; r < 16; ++r) acc[kb][r] = 0.f;
#pragma unroll 2
            for (int step = 0; step < 8; ++step) {
                const bf16x8 B = *(const bf16x8*)(Q + tok * 2048 + h * 256 + half * 128 + 16 * step + 8 * hh);
#pragma unroll
                for (int kb = 0; kb < 4; ++kb) { const bf16x8 A = *(const bf16x8*)(KEYS + ((size_t)(h * 2 + half) * NKEYS + 32 * kb + r31) * 128 + 16 * step + 8 * hh);
                    acc[kb] = __builtin_amdgcn_mfma_f32_32x32x16_bf16(A, B, acc[kb], 0, 0, 0); }
            }
            int g[4][16];
#pragma unroll
            for (int kb = 0; kb < 4; ++kb) {
#pragma unroll
                for (int r = 0; r < 16; ++r) { const int key = 32 * kb + (r & 3) + 8 * (r >> 2) + 4 * hh; g[kb][r] = (f2key(acc[kb][r]) & ~127) | key; }
                sort16_desc(g[kb]); }
            merge16_desc(g[0], g[1]); merge16_desc(g[2], g[3]); merge16_desc(g[0], g[2]);
            int o[16];
#pragma unroll
            for (int i = 0; i < 16; ++i) o[i] = __shfl_xor(g[0][i], 32);
            merge16_desc(g[0], o);
#pragma unroll
            for (int i = 0; i < 16; ++i) t12[half][i] = g[0][i];
        }
        LAS unsigned char* tab = lds + RING_OFF + wave * 16384 + lane * 36;
#pragma unroll
        for (int w = 0; w < 8; ++w) { const int hf = w >> 2, i0 = 4 * (w & 3);
            *(LAS unsigned*)(tab + 4 * w) = (unsigned)(t12[hf][i0] & 127) | ((unsigned)(t12[hf][i0 + 1] & 127) << 8) | ((unsigned)(t12[hf][i0 + 2] & 127) << 16) | ((unsigned)(t12[hf][i0 + 3] & 127) << 24); }
        float f1[16], f2[16];
#pragma unroll
        for (int i = 0; i < 16; ++i) { f1[i] = key2f(t12[0][i] & ~127); f2[i] = key2f(t12[1][i] & ~127); }
        int c[4][16];
#pragma unroll
        for (int gidx = 0; gidx < 4; ++gidx)
#pragma unroll
            for (int k = 0; k < 16; ++k) c[gidx][k] = (int)0x80000000;
#define CAND(gi, k, i, j) c[gi][k] = (f2key(f1[i] + f2[j]) & ~255) | ((i) * 16 + (j))
#pragma unroll
        for (int j = 0; j < 16; ++j) CAND(0, j, 0, j);
#pragma unroll
        for (int j = 0; j < 8; ++j) CAND(1, j, 1, j);
#pragma unroll
        for (int j = 0; j < 5; ++j) CAND(1, 8 + j, 2, j);
#pragma unroll
        for (int j = 0; j < 3; ++j) CAND(1, 13 + j, 4, j);
#pragma unroll
        for (int j = 0; j < 4; ++j) CAND(2, j, 3, j);
#pragma unroll
        for (int j = 0; j < 2; ++j) { CAND(2, 4 + j, 5, j); CAND(2, 6 + j, 6, j); CAND(2, 8 + j, 7, j); }
#pragma unroll
        for (int i = 8; i < 14; ++i) CAND(2, 10 + (i - 8), i, 0);
        CAND(3, 0, 14, 0); CAND(3, 1, 15, 0);
#undef CAND
        sort16_desc(c[1]); sort16_desc(c[2]); sort16_desc(c[3]);
        merge16_desc(c[0], c[1]); merge16_desc(c[0], c[2]); merge16_desc(c[0], c[3]);
        float sc[16]; int se[16];
        const float m0 = key2f(c[0][0] & ~255); float sum = 0.f;
#pragma unroll
        for (int it = 0; it < 16; ++it) { const int id = c[0][it] & 255; const int a = tab[id >> 4], b = tab[16 + (id & 15)];
            se[it] = a * NKEYS + b; sc[it] = __expf(key2f(c[0][it] & ~255) - m0); sum += sc[it]; }
        const float inv = 1.f / sum;
        if (hh == 0) {
            unsigned* ip = PK + tok * NSEL + h * TOPK;
#pragma unroll
            for (int it = 0; it < 16; it += 4) { v4u o;
                o.x = ((unsigned)se[it] << 16) | (unsigned)__builtin_bit_cast(unsigned short, (_Float16)(sc[it] * inv));
                o.y = ((unsigned)se[it + 1] << 16) | (unsigned)__builtin_bit_cast(unsigned short, (_Float16)(sc[it + 1] * inv));
                o.z = ((unsigned)se[it + 2] << 16) | (unsigned)__builtin_bit_cast(unsigned short, (_Float16)(sc[it + 2] * inv));
                o.w = ((unsigned)se[it + 3] << 16) | (unsigned)__builtin_bit_cast(unsigned short, (_Float16)(sc[it + 3] * inv));
                *(v4u*)(ip + it) = o; }
        }
    }
    GRID_BAR();
    u32x2* ST2 = (u32x2*)(ws + WS_Q);
    {
        constexpr int TPW = 4, NB = 8, NPAIR = TPW * NSEL, NBATCH = NPAIR / NB, NSET = 3;
        LAS unsigned char* hl = lds + RING_OFF + wave * 16384;
        LAS unsigned* strm = (LAS unsigned*)(hl + TPW * 2048);
        LAS float* hsl = (LAS float*)(hl + TPW * 1024);
        for (int base = gw * TPW; base < M; base += NGW * TPW) {
            const int lane_outer_ = lane; const size_t grp = (size_t)(base / TPW);
            {
                int lane = lane_outer_; asm volatile("" : "+v"(lane));
                unsigned kv[8];
#pragma unroll
                for (int r = 0; r < 8; ++r) { const int t = r >> 1; const unsigned pk = PK[(size_t)(base + t) * NSEL + (r & 1) * 64 + lane]; const unsigned idx = pk >> 16;
                    kv[r] = ((idx >> 9) << 27) | ((unsigned)t << 25) | ((idx & 511u) << 16) | (pk & 0xffffu); }
                sort512_asc(kv, lane);
#pragma unroll
                for (int r = 0; r < 8; ++r) strm[lane + 64 * r] = kv[r];
            }
            int lane = lane_outer_; asm volatile("" : "+v"(lane));
#pragma unroll
            for (int t = 0; t < TPW; ++t) { float hf_[16];
                unpack8(*(const v4u*)(H1 + (size_t)(base + t) * D + 16 * lane), *(float(*)[8])&hf_[0]); unpack8(*(const v4u*)(H1 + (size_t)(base + t) * D + 16 * lane + 8), *(float(*)[8])&hf_[8]);
                float mx_ = 0.f;
#pragma unroll
                for (int i = 0; i < 16; ++i) mx_ = fmaxf(mx_, fabsf(hf_[i]));
#pragma unroll
                for (int o = 1; o < 64; o <<= 1) mx_ = fmaxf(mx_, __shfl_xor(mx_, o));
                mx_ = fmaxf(mx_, 1e-30f); const float si_ = 127.f / mx_; v4u hq_; unsigned wq_[4];
#pragma unroll
                for (int j = 0; j < 4; ++j) wq_[j] = ((unsigned)__float2int_rn(hf_[4 * j] * si_) & 0xffu) | (((unsigned)__float2int_rn(hf_[4 * j + 1] * si_) & 0xffu) << 8) | (((unsigned)__float2int_rn(hf_[4 * j + 2] * si_) & 0xffu) << 16) | (((unsigned)__float2int_rn(hf_[4 * j + 3] * si_) & 0xffu) << 24);
                hq_.x = wq_[0]; hq_.y = wq_[1]; hq_.z = wq_[2]; hq_.w = wq_[3];
                *(LAS v4u*)(hl + t * 1024 + 16 * lane) = hq_; if (lane == 0) hsl[t] = mx_ * (1.f / 127.f); }
            v4u uu[NSET][NB]; unsigned keyl[NSET]; f32x2v scl[NSET];
#define PEER_ISSUE(S, B) do { const int il_ = min((B) * NB + (lane >> 3), NPAIR - 1); keyl[S] = strm[il_]; \
        const unsigned el_ = ((keyl[S] >> 27) << 9) | ((keyl[S] >> 16) & 511u); scl[S] = *(const f32x2v*)(SC + 2 * (size_t)el_); \
        _Pragma("unroll") for (int q = 0; q < NB; ++q) { const unsigned kq_ = (unsigned)__builtin_amdgcn_readlane((int)keyl[S], 8 * q); const size_t e_ = ((kq_ >> 27) << 9) | ((kq_ >> 16) & 511u); \
            uu[S][q] = *(const v4u*)(U8 + e_ * D + 16 * lane); } } while (0)
#define PEER_COMPUTE(S, B) do { float d_[NB]; \
        _Pragma("unroll") for (int q = 0; q < NB; ++q) { const unsigned tq_ = ((unsigned)__builtin_amdgcn_readlane((int)keyl[S], 8 * q) >> 25) & 3u; \
            const v4u hv_ = *(const LAS v4u*)(hl + tq_ * 1024 + 16 * lane); const v4u w_ = uu[S][q]; \
            int a_ = __builtin_amdgcn_sdot4((int)w_.x, (int)hv_.x, 0, false); a_ = __builtin_amdgcn_sdot4((int)w_.y, (int)hv_.y, a_, false); \
            a_ = __builtin_amdgcn_sdot4((int)w_.z, (int)hv_.z, a_, false); a_ = __builtin_amdgcn_sdot4((int)w_.w, (int)hv_.w, a_, false); d_[q] = (float)a_; } \
        const float rr_ = reduce8(d_, lane); \
        const float gl_ = (float)__builtin_bit_cast(_Float16, (unsigned short)(keyl[S] & 0xffffu)); \
        const float hs_ = hsl[(keyl[S] >> 25) & 3u]; \
        const float cfv_ = gl_ * scl[S].y * gelu_as(scl[S].x * hs_ * rr_); \
        if ((lane & 7) == 0 && ((B) * NB + (lane >> 3)) < NPAIR) { u32x2 o_; o_.x = keyl[S]; o_.y = __float_as_uint(cfv_); ST2[grp * NPAIR + (B) * NB + (lane >> 3)] = o_; } } while (0)
            PEER_ISSUE(0, 0); PEER_ISSUE(1, 1);
            for (int b = 0; b < NBATCH + 2; b += 3) {
                PEER_ISSUE(2, b + 2); PEER_COMPUTE(0, b);
                PEER_ISSUE(0, b + 3); PEER_COMPUTE(1, b + 1);
                PEER_ISSUE(1, b + 4); PEER_COMPUTE(2, b + 2);
            }
#undef PEER_ISSUE
#undef PEER_COMPUTE
            LDS_WAIT(); asm volatile("" ::: "memory");
        }
    }
    GRID_BAR();
    {
        constexpr int TPW = 4, NB = 8, NPAIR = TPW * NSEL, NBATCH = NPAIR / NB, NSET = 3;
        LAS u32x2* st = (LAS u32x2*)(lds + RING_OFF + wave * 16384);
        for (int base = gw * TPW; base < M; base += NGW * TPW) {
            const size_t grp = (size_t)(base / TPW);
#pragma unroll
            for (int i = 0; i < 4; ++i) { const v4u e2 = *(const v4u*)((const unsigned*)(ST2 + grp * NPAIR) + (i * 64 + lane) * 4); *(LAS v4u*)((LAS unsigned*)st + (i * 64 + lane) * 4) = e2; }
            f32x2v acc2[TPW][8];
#pragma unroll
            for (int t = 0; t < TPW; ++t)
#pragma unroll
                for (int i = 0; i < 8; ++i) acc2[t][i] = (f32x2v){0.f, 0.f};
            v4u vv[NSET][NB]; u32x2 ent[NSET];
#define PEER_ISSUE(S, B) do { const int iu_ = (B) * NB + (lane >> 3); ent[S] = st[min(iu_, NPAIR - 1)]; if (iu_ >= NPAIR) ent[S].y = 0u; \
        _Pragma("unroll") for (int q = 0; q < NB; ++q) { const unsigned kq_ = (unsigned)__builtin_amdgcn_readlane((int)ent[S].x, 8 * q); const size_t e_ = ((kq_ >> 27) << 9) | ((kq_ >> 16) & 511u); \
            vv[S][q] = *(const v4u*)(V8 + e_ * D + 16 * lane); } } while (0)
#define PK_FMA_SEL4(I) asm volatile( \
        "s_cmp_lt_u32 %21, 2\n\ts_cbranch_scc0 2f\n\ts_cmp_eq_u32 %21, 0\n\ts_cbranch_scc0 1f\n\t" \
        "v_pk_fma_f32 %0, %20, %16, %0\n\tv_pk_fma_f32 %1, %20, %17, %1\n\tv_pk_fma_f32 %2, %20, %18, %2\n\tv_pk_fma_f32 %3, %20, %19, %3\n\ts_branch 9f\n" \
        "1:\n\tv_pk_fma_f32 %4, %20, %16, %4\n\tv_pk_fma_f32 %5, %20, %17, %5\n\tv_pk_fma_f32 %6, %20, %18, %6\n\tv_pk_fma_f32 %7, %20, %19, %7\n\ts_branch 9f\n" \
        "2:\n\ts_cmp_eq_u32 %21, 2\n\ts_cbranch_scc0 3f\n\t" \
        "v_pk_fma_f32 %8, %20, %16, %8\n\tv_pk_fma_f32 %9, %20, %17, %9\n\tv_pk_fma_f32 %10, %20, %18, %10\n\tv_pk_fma_f32 %11, %20, %19, %11\n\ts_branch 9f\n" \
        "3:\n\tv_pk_fma_f32 %12, %20, %16, %12\n\tv_pk_fma_f32 %13, %20, %17, %13\n\tv_pk_fma_f32 %14, %20, %18, %14\n\tv_pk_fma_f32 %15, %20, %19, %15\n" \
        "9:\n" \
        : "+v"(acc2[0][I]), "+v"(acc2[0][I + 1]), "+v"(acc2[0][I + 2]), "+v"(acc2[0][I + 3]), "+v"(acc2[1][I]), "+v"(acc2[1][I + 1]), "+v"(acc2[1][I + 2]), "+v"(acc2[1][I + 3]), \
          "+v"(acc2[2][I]), "+v"(acc2[2][I + 1]), "+v"(acc2[2][I + 2]), "+v"(acc2[2][I + 3]), "+v"(acc2[3][I]), "+v"(acc2[3][I + 1]), "+v"(acc2[3][I + 2]), "+v"(acc2[3][I + 3]) \
        : "v"(vf2_[I]), "v"(vf2_[I + 1]), "v"(vf2_[I + 2]), "v"(vf2_[I + 3]), "s"(cf2_), "s"(tq_) : "scc")
#define PEER_COMPUTE(S, B) do { \
        _Pragma("unroll") for (int q = 0; q < NB; ++q) { const unsigned kq2_ = (unsigned)__builtin_amdgcn_readlane((int)ent[S].x, 8 * q); const unsigned tq_ = (kq2_ >> 25) & 3u; \
            const unsigned cfb_ = (unsigned)__builtin_amdgcn_readlane((int)ent[S].y, 8 * q); const unsigned long long cf2_ = ((unsigned long long)cfb_ << 32) | cfb_; \
            const unsigned ww_[4] = {vv[S][q].x, vv[S][q].y, vv[S][q].z, vv[S][q].w}; f32x2v vf2_[8]; \
            _Pragma("unroll") for (int j = 0; j < 4; ++j) { vf2_[2 * j] = __builtin_amdgcn_cvt_pk_f32_fp8((int)ww_[j], false); vf2_[2 * j + 1] = __builtin_amdgcn_cvt_pk_f32_fp8((int)ww_[j], true); } \
            PK_FMA_SEL4(0); PK_FMA_SEL4(4); } } while (0)
            PEER_ISSUE(0, 0); PEER_ISSUE(1, 1);
            for (int b = 0; b < NBATCH + 2; b += 3) {
                PEER_ISSUE(2, b + 2); PEER_COMPUTE(0, b);
                PEER_ISSUE(0, b + 3); PEER_COMPUTE(1, b + 1);
                PEER_ISSUE(1, b + 4); PEER_COMPUTE(2, b + 2);
            }
#undef PEER_ISSUE
#undef PEER_COMPUTE
#undef PK_FMA_SEL4
#pragma unroll
            for (int t = 0; t < TPW; ++t) {
                const size_t m = (size_t)(base + t);
                float hv[16], gv[16], pv[16];
                unpack8(*(const v4u*)(H1 + m * D + 16 * lane), *(float(*)[8])&hv[0]); unpack8(*(const v4u*)(H1 + m * D + 16 * lane + 8), *(float(*)[8])&hv[8]);
                unpack8(*(const v4u*)(GP + m * D + 16 * lane), *(float(*)[8])&gv[0]); unpack8(*(const v4u*)(GP + m * D + 16 * lane + 8), *(float(*)[8])&gv[8]);
                unpack8(*(const v4u*)(PP + m * D + 16 * lane), *(float(*)[8])&pv[0]); unpack8(*(const v4u*)(PP + m * D + 16 * lane + 8), *(float(*)[8])&pv[8]);
                float y[16], s = 0.f;
#pragma unroll
                for (int i = 0; i < 16; ++i) { y[i] = hv[i] * ALPHA + ((i & 1) ? acc2[t][i >> 1].y : acc2[t][i >> 1].x) + sigmoidf_(gv[i]) * pv[i]; s += y[i]; }
                const float mean = wave_sum(s) * (1.f / D); float q2 = 0.f;
#pragma unroll
                for (int i = 0; i < 16; ++i) { y[i] -= mean; q2 += y[i] * y[i]; }
                const float rstd = 1.f / sqrtf(wave_sum(q2) * (1.f / D) + LN_EPS);
#pragma unroll
                for (int c = 0; c < 4; ++c) { const int col = 16 * lane + 4 * c;
                    const f32x4 gg = *(const f32x4*)(ln2_g + col), bb = *(const f32x4*)(ln2_b + col);
                    f32x4 o; o.x = y[4 * c] * rstd * gg.x + bb.x; o.y = y[4 * c + 1] * rstd * gg.y + bb.y; o.z = y[4 * c + 2] * rstd * gg.z + bb.z; o.w = y[4 * c + 3] * rstd * gg.w + bb.w;
                    *(f32x4*)(args.out + m * D + col) = o; }
            }
            LDS_WAIT(); asm volatile("" ::: "memory");
        }
    }

}

extern "C" void kernel_launch(void* const* d_in, const int* in_sizes, int n_in, void* d_out, int out_size, void* d_ws, size_t ws_size, hipStream_t stream) {
    static int grid = 0;
    if (grid == 0) {
        if (n_in != 27 || in_sizes[0] != M * D || out_size != M * D || ws_size < WS_END) { fprintf(stderr, "kernel_launch: unexpected shapes (n_in %d, in0 %d, out %d, ws %zu)\n", n_in, n_in > 0 ? in_sizes[0] : -1, out_size, ws_size); grid = -1; return; }
        int dev = 0, cus = 0, per_cu = 0;
        if (hipGetDevice(&dev) != hipSuccess || hipDeviceGetAttribute(&cus, hipDeviceAttributeMultiprocessorCount, dev) != hipSuccess) { grid = -1; return; }
        if (hipFuncSetAttribute((const void*)fwd_kernel, hipFuncAttributeMaxDynamicSharedMemorySize, LDS_BYTES) != hipSuccess) { fprintf(stderr, "kernel_launch: hipFuncSetAttribute failed\n"); grid = -1; return; }
        if (hipOccupancyMaxActiveBlocksPerMultiprocessor(&per_cu, (const void*)fwd_kernel, NWAVES * 64, LDS_BYTES) != hipSuccess || per_cu < 1) fprintf(stderr, "kernel_launch: occupancy query says %d\n", per_cu);
        (void)hipGetLastError();
        grid = cus;
    }
    if (grid < 0) return;
    if (hipMemsetAsync((char*)d_ws + WS_CTL, 0, CTL_ZERO_BYTES, stream) != hipSuccess) return;
    Args a{};
    for (int i = 0; i < 27; ++i) a.in[i] = (const float*)d_in[i];
    a.out = (float*)d_out; a.ws = (unsigned char*)d_ws;
    hipLaunchKernelGGL(fwd_kernel, dim3(grid), dim3(NWAVES * 64), LDS_BYTES, stream, a);
}
```

```cpp
#include <hip/hip_runtime.h>
#include <cstdio>
#include <cstdint>
namespace pg8 {
#define PG8_LAS __attribute__((address_space(3)))
typedef unsigned short bf16_t;
typedef short bf16x8 __attribute__((ext_vector_type(8)));
typedef float f32x4 __attribute__((ext_vector_type(4)));
typedef unsigned u32x4 __attribute__((ext_vector_type(4)));
constexpr int BM = 256, BK = 64, HALF = 128, HTB = HALF * BK * 2  , STAGE_BYTES = 8 * HTB, NXCD = 8, WGM = 8;

__host__ __device__ __forceinline__ int lds_byte(int r, int c) { const int st = (r >> 4) * 2 + (c >> 5), rr = r & 15, cc = c & 31, ob = rr * 64 + cc * 2; return st * 1024 + (ob ^ (((ob >> 9) & 1) << 5)); }
__host__ __device__ __forceinline__ void stage_rc(int b, int& R, int& C) { const int st = b / 1024, sb = b % 1024, swz = sb ^ (((sb >> 9) & 1) << 5); R = (st >> 1) * 16 + swz / 64; C = (st & 1) * 32 + (swz % 64) / 2; }
__host__ __device__ __forceinline__ int perm32(int rho) { const int n = rho >> 4, i = rho & 15; return 8 * (i >> 2) + 4 * n + (i & 3); }

struct Unit { int pm, pn; };
struct Gemm { const bf16_t* A; const bf16_t* Bt; int M, N, K; };

struct StaticOrder {
    int nM, nN, nwg, G, c;
    __host__ __device__ void init(int M, int N, int G_, int c_) { nM = M / BM; nN = N / BM; nwg = nM * nN; G = G_; c = c_; }
    __host__ __device__ bool next(int i, Unit& u) const {
        const long L = (long)i * G + c; if (L >= nwg) return false;
        int wgid = (int)L; { const int q = nwg / NXCD, r = nwg % NXCD, xcd = wgid % NXCD, off = wgid / NXCD; wgid = (xcd < r ? xcd * (q + 1) : r * (q + 1) + (xcd - r) * q) + off; }
        const int nig = WGM * nN, gid = wgid / nig, fm = gid * WGM, gsz = (nM - fm) < WGM ? (nM - fm) : WGM;
        u.pm = fm + ((wgid % nig) % gsz); u.pn = (wgid % nig) / gsz; return true;
    }
    __device__ __forceinline__ void a_ready(const Unit&) const {}
    __device__ __forceinline__ void done(const Unit&) const {}
};

__device__ __forceinline__ unsigned cvt_pk_bf16(float lo, float hi) { unsigned r; asm volatile("v_cvt_pk_bf16_f32 %0, %1, %2" : "=v"(r) : "v"(lo), "v"(hi)); return r; }
typedef float f32x2 __attribute__((ext_vector_type(2)));
__device__ __forceinline__ f32x2 gelu_pk(f32x2 v) {
    const f32x2 av = __builtin_elementwise_abs(v), d = av * 0.2316418882f + 1.0f;
    f32x2 t; t.x = __builtin_amdgcn_rcpf(d.x); t.y = __builtin_amdgcn_rcpf(d.y);
    f32x2 q = t * 0.5307027145f + (-0.7265760135f); q = q * t + 0.7107068705f; q = q * t + (-0.142248368f); q = q * t + 0.127414796f; q = q * t;
    const f32x2 s = (v * v) * (-0.72134752044f);
    f32x2 e; e.x = __builtin_amdgcn_exp2f(s.x); e.y = __builtin_amdgcn_exp2f(s.y);
    const f32x2 m = v * (q * e), r = v - m;
    f32x2 o; o.x = v.x < 0.f ? m.x : r.x; o.y = v.y < 0.f ? m.y : r.y; return o;
}

template <int ACT  > struct EpiBf16 {
    static constexpr bool PERM = true, AFTER_DRAIN = false; static_assert(ACT == 0 || ACT == 1, "EpiBf16: ACT is 0 (none) or 1 (gelu_pk)");
    bf16_t* O; int ldc; const float* bias; int split_cols; size_t split_stride; float scale0;
    __device__ __forceinline__ void operator()(const f32x4 (&acc)[2][2][4][2], const Unit& u, int wr, int wc, int fr, int fq) const {
        const int row0 = u.pm * BM + wr * 64 + fr; int colt = u.pn * BM; bf16_t* base = O;
        float sc = 1.f; if (split_cols) { const int t = colt / split_cols; base += (size_t)t * split_stride; colt -= t * split_cols; if (t == 0) sc = scale0; }
        const int col0 = colt + wc * 32 + 8 * fq, bcol0 = u.pn * BM + wc * 32 + 8 * fq;
        f32x4 bv[2][2];
#pragma unroll
        for (int bj = 0; bj < 2; ++bj)
#pragma unroll
            for (int n = 0; n < 2; ++n) bv[bj][n] = bias ? *(const f32x4*)(bias + bcol0 + bj * HALF + 4 * n) : (f32x4){0.f, 0.f, 0.f, 0.f};
#pragma unroll
        for (int ai = 0; ai < 2; ++ai)
#pragma unroll
            for (int m = 0; m < 4; ++m) { bf16_t* rowp = base + (size_t)(row0 + ai * HALF + m * 16) * ldc + col0;
#pragma unroll
                for (int bj = 0; bj < 2; ++bj) { f32x4 v0 = acc[ai][bj][m][0] + bv[bj][0], v1 = acc[ai][bj][m][1] + bv[bj][1];
                    if (ACT == 1) { f32x2 a = gelu_pk((f32x2){v0[0], v0[1]}), b = gelu_pk((f32x2){v0[2], v0[3]}), c = gelu_pk((f32x2){v1[0], v1[1]}), d = gelu_pk((f32x2){v1[2], v1[3]});
                        v0 = (f32x4){a.x, a.y, b.x, b.y}; v1 = (f32x4){c.x, c.y, d.x, d.y}; }
                    v0 = v0 * sc; v1 = v1 * sc; u32x4 w; w.x = cvt_pk_bf16(v0[0], v0[1]); w.y = cvt_pk_bf16(v0[2], v0[3]); w.z = cvt_pk_bf16(v1[0], v1[1]); w.w = cvt_pk_bf16(v1[2], v1[3]);
                    *(u32x4*)(rowp + bj * HALF) = w; } }
    }
};

template <class Epi, class Sched, bool ALIGN_EPI = false, bool SP2 = false>
__device__ __forceinline__ void gemm_phase(PG8_LAS unsigned char* lds, const Gemm g, const Sched& S, const Epi& E) {
    const int tid = threadIdx.x, wid = __builtin_amdgcn_readfirstlane(tid >> 6), lane = tid & 63, wr = wid >> 2, wc = wid & 3, fr = lane & 15, fq = lane >> 4;
    const int K = g.K, nt = K / BK;
    unsigned voffA[2], voffB[2];
#pragma unroll
    for (int i = 0; i < 2; ++i) { int R, C; stage_rc(tid * 16 + i * 8192, R, C); const int Rb = Epi::PERM ? ((R & ~31) + perm32(R & 31)) : R;
        voffA[i] = (unsigned)(R * K + C) * 2u; voffB[i] = (unsigned)(Rb * K + C) * 2u; }
    const size_t kstep = (size_t)(BK * 2);
    const size_t hstep = (size_t)HALF * K * 2;
    const size_t tstep = 2 * hstep;
    const unsigned ldsw = (unsigned)wid * 1024u;
    const int aoff = lds_byte(wr * 64 + fr, fq * 8), boff = lds_byte(wc * 32 + fr, fq * 8);
#define PG8_SA(b, h) (((b) * 2 + (h)) * HTB)
#define PG8_SB(b, h) ((4 + (b) * 2 + (h)) * HTB)
#define PG8_STAGE(bufoff, gbase, voff) do { _Pragma("unroll") for (int _i = 0; _i < 2; ++_i) \
        __builtin_amdgcn_global_load_lds((const unsigned*)((const char*)(gbase) + (voff)[_i]), (PG8_LAS unsigned*)(lds + (bufoff) + ldsw + _i * 8192), 16, 0, 0); } while (0)
#define PG8_LDA(dst, b, h) do { _Pragma("unroll") for (int m = 0; m < 4; ++m) _Pragma("unroll") for (int k = 0; k < 2; ++k) dst[m][k] = *(const PG8_LAS bf16x8*)(lds + PG8_SA(b, h) + aoff + m * 2048 + k * 1024); } while (0)
#define PG8_LDB(dst, b, h) do { _Pragma("unroll") for (int n = 0; n < 2; ++n) _Pragma("unroll") for (int k = 0; k < 2; ++k) dst[n][k] = *(const PG8_LAS bf16x8*)(lds + PG8_SB(b, h) + boff + n * 2048 + k * 1024); } while (0)
#define PG8_MMA(ai, bj, At, Bt) do { __builtin_amdgcn_s_setprio(1); _Pragma("unroll") for (int m = 0; m < 4; ++m) _Pragma("unroll") for (int n = 0; n < 2; ++n) _Pragma("unroll") for (int k = 0; k < 2; ++k) \
        acc[ai][bj][m][n] = __builtin_amdgcn_mfma_f32_16x16x32_bf16(Bt[n][k], At[m][k], acc[ai][bj][m][n], 0, 0, 0); __builtin_amdgcn_s_setprio(0); } while (0)
#define PG8_WAIT_V(n) asm volatile("s_waitcnt vmcnt(" #n ")" ::: "memory")
#define PG8_WAIT_L(n) asm volatile("s_waitcnt lgkmcnt(" #n ")" ::: "memory")
#define PG8_BAR __builtin_amdgcn_s_barrier()
#define PG8_SCHED __builtin_amdgcn_sched_barrier(0)
    Unit cur, nxt; int ui = 0;
    if (!S.next(0, cur)) return;
    f32x4 acc[2][2][4][2];
#pragma unroll
    for (int a = 0; a < 2; ++a)
#pragma unroll
        for (int b = 0; b < 2; ++b)
#pragma unroll
            for (int m = 0; m < 4; ++m)
#pragma unroll
                for (int n = 0; n < 2; ++n) acc[a][b][m][n] = (f32x4){0.f, 0.f, 0.f, 0.f};
    bf16x8 At[4][2], B0[2][2], B1[2][2];
    const char* cA = (const char*)g.A + (size_t)cur.pm * tstep; const char* cB = (const char*)g.Bt + (size_t)cur.pn * tstep;
    S.a_ready(cur);
    if constexpr (SP2) {
        PG8_STAGE(PG8_SB(0, 0), cB, voffB); PG8_STAGE(PG8_SB(0, 1), cB + hstep, voffB); PG8_STAGE(PG8_SA(0, 0), cA, voffA); PG8_STAGE(PG8_SA(0, 1), cA + hstep, voffA);
        if (wr == 1) PG8_BAR;
        PG8_WAIT_V(2); PG8_BAR;
        PG8_STAGE(PG8_SB(1, 0), cB + kstep, voffB); PG8_STAGE(PG8_SA(1, 0), cA + kstep, voffA); PG8_STAGE(PG8_SB(1, 1), cB + hstep + kstep, voffB);
        PG8_WAIT_V(6); PG8_BAR;
    } else {
        PG8_STAGE(PG8_SB(0, 0), cB, voffB); PG8_STAGE(PG8_SA(0, 0), cA, voffA); PG8_STAGE(PG8_SB(0, 1), cB + hstep, voffB); PG8_STAGE(PG8_SA(0, 1), cA + hstep, voffA);
        if (wr == 1) PG8_BAR;
        PG8_WAIT_V(4); PG8_BAR;
        PG8_STAGE(PG8_SB(1, 0), cB + kstep, voffB); PG8_STAGE(PG8_SA(1, 0), cA + kstep, voffA); PG8_STAGE(PG8_SB(1, 1), cB + hstep + kstep, voffB);
        PG8_WAIT_V(6); PG8_BAR;
    }
    for (;;) {
        const bool has_next = S.next(ui + 1, nxt);
        const char* nA = has_next ? (const char*)g.A + (size_t)nxt.pm * tstep : cA; const char* nB = has_next ? (const char*)g.Bt + (size_t)nxt.pn * tstep : cB;
        for (int t = 0; t < nt; t += 2) {
            const bool last = (t == nt - 2);
            const char* a1 = cA + (size_t)(t + 1) * kstep;
            const char* a2 = last ? nA : cA + (size_t)(t + 2) * kstep; const char* b2 = last ? nB : cB + (size_t)(t + 2) * kstep;
            const char* a3 = a2 + kstep; const char* b3 = b2 + kstep;
            if (last && has_next) S.a_ready(nxt);
            if constexpr (SP2) {
            PG8_LDB(B0, 0, 0); PG8_LDB(B1, 0, 1); PG8_SCHED; PG8_LDA(At, 0, 0); PG8_STAGE(PG8_SA(1, 1), a1 + hstep, voffA);
            PG8_WAIT_V(8); PG8_WAIT_L(0); PG8_BAR; PG8_MMA(0, 0, At, B0); PG8_MMA(0, 1, At, B1); PG8_BAR; PG8_SCHED;
            PG8_LDA(At, 0, 1); PG8_STAGE(PG8_SB(0, 0), b2, voffB); PG8_STAGE(PG8_SB(0, 1), b2 + hstep, voffB); PG8_STAGE(PG8_SA(0, 0), a2, voffA);
            PG8_WAIT_V(8); PG8_WAIT_L(0); PG8_BAR; PG8_MMA(1, 0, At, B0); PG8_MMA(1, 1, At, B1); PG8_BAR; PG8_SCHED;
            PG8_LDB(B0, 1, 0); PG8_LDB(B1, 1, 1); PG8_SCHED; PG8_LDA(At, 1, 0); PG8_STAGE(PG8_SA(0, 1), a2 + hstep, voffA);
            PG8_WAIT_V(8); PG8_WAIT_L(0); PG8_BAR; PG8_MMA(0, 0, At, B0); PG8_MMA(0, 1, At, B1); PG8_BAR; PG8_SCHED;
            PG8_LDA(At, 1, 1); PG8_STAGE(PG8_SB(1, 0), b3, voffB); PG8_STAGE(PG8_SB(1, 1), b3 + hstep, voffB); PG8_STAGE(PG8_SA(1, 0), a3, voffA);
            PG8_WAIT_V(8); PG8_WAIT_L(0); PG8_BAR; PG8_MMA(1, 0, At, B0); PG8_MMA(1, 1, At, B1); PG8_BAR; PG8_SCHED;
            } else {
            PG8_LDB(B0, 0, 0); PG8_SCHED; PG8_LDA(At, 0, 0); PG8_STAGE(PG8_SA(1, 1), a1 + hstep, voffA);
            PG8_WAIT_L(8); PG8_BAR; PG8_WAIT_L(0); PG8_MMA(0, 0, At, B0); PG8_BAR; PG8_SCHED;
            PG8_LDB(B1, 0, 1); PG8_STAGE(PG8_SB(0, 0), b2, voffB);
            PG8_BAR; PG8_WAIT_L(0); PG8_MMA(0, 1, At, B1); PG8_BAR;
            PG8_LDA(At, 0, 1); PG8_STAGE(PG8_SA(0, 0), a2, voffA);
            PG8_BAR; PG8_WAIT_L(0); PG8_MMA(1, 0, At, B0); PG8_BAR; PG8_SCHED;
            PG8_STAGE(PG8_SB(0, 1), b2 + hstep, voffB);
            PG8_WAIT_V(6); PG8_BAR; PG8_MMA(1, 1, At, B1); PG8_BAR;
            PG8_LDB(B0, 1, 0); PG8_SCHED; PG8_LDA(At, 1, 0); PG8_STAGE(PG8_SA(0, 1), a2 + hstep, voffA);
            PG8_WAIT_L(8); PG8_BAR; PG8_WAIT_L(0); PG8_MMA(0, 0, At, B0); PG8_BAR; PG8_SCHED;
            PG8_LDB(B1, 1, 1); PG8_STAGE(PG8_SB(1, 0), b3, voffB);
            PG8_BAR; PG8_WAIT_L(0); PG8_MMA(0, 1, At, B1); PG8_BAR;
            PG8_LDA(At, 1, 1); PG8_STAGE(PG8_SA(1, 0), a3, voffA);
            PG8_BAR; PG8_WAIT_L(0); PG8_MMA(1, 0, At, B0); PG8_BAR; PG8_SCHED;
            PG8_STAGE(PG8_SB(1, 1), b3 + hstep, voffB);
            PG8_WAIT_V(6); PG8_BAR; PG8_MMA(1, 1, At, B1); PG8_BAR;
            }
        }
        if constexpr (ALIGN_EPI) { if (wr == 0) PG8_BAR; }
        if constexpr (!Epi::AFTER_DRAIN) { E(acc, cur, wr, wc, fr, fq); S.done(cur); }
        if (!has_next) break;
#pragma unroll
        for (int a = 0; a < 2; ++a)
#pragma unroll
            for (int b = 0; b < 2; ++b)
#pragma unroll
                for (int m = 0; m < 4; ++m)
#pragma unroll
                    for (int n = 0; n < 2; ++n) acc[a][b][m][n] = (f32x4){0.f, 0.f, 0.f, 0.f};
        cur = nxt; cA = nA; cB = nB; ++ui;
        if constexpr (ALIGN_EPI) { if (wr == 1) PG8_BAR; }
    }
    PG8_WAIT_V(0);
    if constexpr (!ALIGN_EPI) { if (wr == 0) PG8_BAR; }
    PG8_BAR;
    if constexpr (Epi::AFTER_DRAIN) { E.fused(acc, cur, wr, wc, fr, fq, lds, wid, lane); S.done(cur); }
#undef PG8_SA
#undef PG8_SB
#undef PG8_STAGE
#undef PG8_LDA
#undef PG8_LDB
#undef PG8_MMA
#undef PG8_WAIT_V
#undef PG8_WAIT_L
#undef PG8_BAR
#undef PG8_SCHED
}
}
#define GAS __attribute__((address_space(1)))
#define LAS __attribute__((address_space(3)))
typedef unsigned short bf16;
typedef unsigned v4u __attribute__((ext_vector_type(4)));
typedef float f32x4 __attribute__((ext_vector_type(4)));
typedef short bf16x8 __attribute__((ext_vector_type(8)));
typedef GAS unsigned gu32;
typedef GAS unsigned long long gu64;
#define RLX_AGENT __ATOMIC_RELAXED, __HIP_MEMORY_SCOPE_AGENT
#define LDS_WAIT() asm volatile("s_waitcnt lgkmcnt(0)" ::: "memory")
#define VM_WAIT() asm volatile("s_waitcnt vmcnt(0)" ::: "memory")
__device__ __forceinline__ unsigned long long rt() { return __builtin_amdgcn_s_memrealtime(); }
__device__ __forceinline__ unsigned f2bf(float f) { unsigned u = __builtin_bit_cast(unsigned, f); return (u + 0x7fffu + ((u >> 16) & 1u)) >> 16; }
__device__ __forceinline__ unsigned pk2(float lo, float hi) { return f2bf(lo) | (f2bf(hi) << 16); }

#define XB_TMO      128
#define XB_XCNT(j)  (256  + 64 * (j))
#define XB_XSUB(j)  (1280 + 64 * (j))
#define XB_XGEN(j)  (2304 + 64 * (j))
#define XB_TOP      3328
#define XB_TOPGEN   3392
#define XCD_BAR_WORDS 3456
#define XB_SPIN_CAP (1u << 21)

__device__ __forceinline__ unsigned xb_ld(unsigned* p)              { return __hip_atomic_load(p, __ATOMIC_RELAXED, __HIP_MEMORY_SCOPE_AGENT); }
__device__ __forceinline__ unsigned xb_add(unsigned* p, unsigned v) { return __hip_atomic_fetch_add(p, v, __ATOMIC_RELAXED, __HIP_MEMORY_SCOPE_AGENT); }
__device__ __forceinline__ unsigned xb_xcc_id() { return (unsigned)__builtin_amdgcn_s_getreg((3 << 11) | 20) & 0xFu; }
#define XB_SPIN(cond, bar) do { unsigned _sp = 0; while (cond) { __builtin_amdgcn_s_sleep(1); \
    if ((++_sp & 255u) == 0u) { if (xb_ld(&(bar)[XB_TMO])) break; if (_sp > XB_SPIN_CAP) { atomicAdd(&(bar)[XB_TMO], 1u); break; } } } } while (0)

struct XcdBarrier {
    unsigned* bar; unsigned x;
    volatile LAS unsigned* st;
};

__device__ __forceinline__ XcdBarrier xcd_barrier_post(unsigned* bar, volatile LAS unsigned* st) {
    XcdBarrier b; b.bar = bar; b.x = xb_xcc_id(); b.st = st;
    if (threadIdx.x == 0) (void)xb_add(&bar[XB_XCNT(b.x)], 1u);
    return b;
}
__device__ __forceinline__ void xcd_barrier_complete(unsigned* bar, unsigned x, unsigned& nloc, unsigned& nx) {
    const unsigned G = gridDim.x * gridDim.y * gridDim.z;
    unsigned sum, cnt, mine, sp = 0u;
    for (;;) {
        sum = 0u; cnt = 0u; mine = 0u;
#pragma unroll
        for (unsigned j = 0; j < 16; ++j) { const unsigned c = xb_ld(&bar[XB_XCNT(j)]); sum += c; cnt += (c > 0u) ? 1u : 0u; mine = (j == x) ? c : mine; }
        if (sum == G) break;
        __builtin_amdgcn_s_sleep(1);
        if ((++sp & 255u) == 0u) { if (xb_ld(&bar[XB_TMO])) break; if (sp > XB_SPIN_CAP) { atomicAdd(&bar[XB_TMO], 1u); break; } }
    }
    nloc = mine > 0u ? mine : 1u; nx = cnt > 0u ? cnt : 1u;
}

__device__ __forceinline__ void xcd_barrier(const XcdBarrier& b) {
    asm volatile("s_waitcnt vmcnt(0)" ::: "memory");
    __syncthreads();
    if (threadIdx.x == 0) {
        unsigned* bar = b.bar;
        __builtin_amdgcn_s_waitcnt(0);
        unsigned nloc = b.st[0], nx = b.st[1];
        if (nloc == 0u) { xcd_barrier_complete(bar, b.x, nloc, nx); b.st[0] = nloc; b.st[1] = nx; }
        const unsigned old = xb_add(&bar[XB_XSUB(b.x)], 1u);
        const unsigned gen = old / nloc;
        if (old + 1u == (gen + 1u) * nloc) {
            __builtin_amdgcn_fence(__ATOMIC_RELEASE, "agent");
            asm volatile("s_waitcnt vmcnt(0)" ::: "memory");
            const unsigned og = xb_add(&bar[XB_TOP], 1u);
            const unsigned tg = og / nx;
            if (og + 1u == (tg + 1u) * nx) xb_add(&bar[XB_TOPGEN], 1u);
            else XB_SPIN(xb_ld(&bar[XB_TOPGEN]) == tg, bar);
            __builtin_amdgcn_fence(__ATOMIC_ACQUIRE, "agent");
            xb_add(&bar[XB_XGEN(b.x)], 1u);
            asm volatile("s_waitcnt vmcnt(0)" ::: "memory");
        } else {
            XB_SPIN(xb_ld(&bar[XB_XGEN(b.x)]) == gen, bar);
            __builtin_amdgcn_fence(__ATOMIC_ACQUIRE, "agent");
            asm volatile("s_waitcnt vmcnt(0)" ::: "memory");
        }
    }
    __syncthreads();
}

constexpr int NWAVES = 8;
constexpr int BATCH = 8, SEQ = 4096, D = 1024, M = BATCH * SEQ;
constexpr int DIN = 2048, CONVW = 512, SGWD = 512, NHEAD = 8, CKER = 31, CHUNK = 128;
constexpr int PHEADS = 8, TOPK = 16, NKEYS = 128, NEXP = 16384, PLE = 256, NSEL = PHEADS * TOPK;
constexpr float ALPHA = 1.18920711500272f;
constexpr float LN_EPS = 1e-5f;

constexpr size_t MiB = 1u << 20;
constexpr size_t WS_CTL = 0, CTL_ZERO_BYTES = 1 * MiB;
constexpr size_t WS_WIN = 2 * MiB, WS_WO = 6 * MiB, WS_WQ = 8 * MiB, WS_WG = 12 * MiB, WS_WP = 14 * MiB, WS_KEYS = 14 * MiB + 512 * 1024, WS_SGW = 15 * MiB, WS_BINP = 15 * MiB + 512 * 1024;
constexpr size_t WS_UT = 16 * MiB, WS_VT = 32 * MiB, WS_SC = 48 * MiB;
constexpr size_t WS_XN = 96 * MiB, WS_H1 = WS_XN;
constexpr size_t WS_PB = 160 * MiB;
constexpr size_t WS_CB = 176 * MiB, WS_GU = 208 * MiB, WS_VN = 240 * MiB;
constexpr size_t WS_PP = 176 * MiB, WS_IDX = 240 * MiB, WS_GW = 256 * MiB;
constexpr size_t WS_MIX = 272 * MiB, WS_GP = WS_MIX;
constexpr size_t WS_Z = 336 * MiB, WS_MIXO = WS_Z, WS_Q = WS_Z;
constexpr size_t WS_END = 464 * MiB;
constexpr int CW_BAR = 4096;

constexpr int RING_OFF = 0, RING_BYTES = 131072;
constexpr int LDSCTL_OFF = RING_BYTES, MISC_OFF = LDSCTL_OFF + 320;
constexpr int LDS_BYTES = 147456;

__device__ __forceinline__ float bf_lo(unsigned u) { return __uint_as_float(u << 16); }
__device__ __forceinline__ float bf_hi(unsigned u) { return __uint_as_float(u & 0xffff0000u); }
__device__ __forceinline__ float wave_sum(float v) {
#pragma unroll
    for (int o = 1; o < 64; o <<= 1) v += __shfl_xor(v, o);
    return v;
}
__device__ __forceinline__ float sigmoidf_(float x) { return 1.f / (1.f + __expf(-x)); }
__device__ __forceinline__ float gelu_exact(float x) { return 0.5f * x * (1.f + erff(x * 0.70710678118654752f)); }

__host__ __device__ __forceinline__ int win_src(int np) {
    const int j = np >> 8, lc = np & 255;
    if (j < 4) return (lc < 128) ? (128 * j + lc) : (512 + 128 * j + (lc - 128));
    const int jj = j - 4, base = (jj < 2) ? 1024 : 1536, head = 4 * (jj & 1) + ((lc >> 5) & 3), ch = 32 * (lc >> 7) + (lc & 31);
    return base + head * 64 + ch;
}

template <bool PERMW>
__device__ __forceinline__ void p0_transpose_item(const float* W, int K, int N, bf16* WT, LAS float* scr, int item, int lane) {
    const int nblk = N / 32, kb = item / nblk, nb = item % nblk, k0 = 64 * kb, n0d = 32 * nb, n0s = PERMW ? win_src(n0d) : n0d;
#pragma unroll 8
    for (int i = 0; i < 32; ++i) { const int kk = 2 * i + (lane >> 5); scr[kk * 33 + (lane & 31)] = W[(size_t)(k0 + kk) * N + n0s + (lane & 31)]; }
    LDS_WAIT(); asm volatile("" ::: "memory");
    const int c = lane & 7;
#pragma unroll
    for (int j = 0; j < 4; ++j) { const int n = (lane >> 3) + 8 * j; const LAS float* s = scr + (8 * c) * 33 + n;
        v4u o; o.x = pk2(s[0 * 33], s[1 * 33]); o.y = pk2(s[2 * 33], s[3 * 33]); o.z = pk2(s[4 * 33], s[5 * 33]); o.w = pk2(s[6 * 33], s[7 * 33]);
        *(GAS v4u*)(WT + (size_t)(n0d + n) * K + k0 + 8 * c) = o; }
    LDS_WAIT(); asm volatile("" ::: "memory");
}

typedef unsigned u32x2 __attribute__((ext_vector_type(2)));
typedef float f32x16 __attribute__((ext_vector_type(16)));

__device__ __forceinline__ void cvt_f32_bf16(const float* src, bf16* dst, size_t n4, size_t gtid, size_t nthr) {
    for (size_t i = gtid; i < n4; i += nthr) { const f32x4 v = ((const f32x4*)src)[i]; u32x2 o; o.x = pk2(v.x, v.y); o.y = pk2(v.z, v.w); ((u32x2*)dst)[i] = o; }
}

__device__ __forceinline__ void ln16(f32x4 (&v)[4], const float* g, const float* b, int lane) {
    float s = 0.f;
#pragma unroll
    for (int j = 0; j < 4; ++j) s += (v[j].x + v[j].y) + (v[j].z + v[j].w);
    const float mean = wave_sum(s) * (1.f / D); float s2 = 0.f;
#pragma unroll
    for (int j = 0; j < 4; ++j) { v[j] = v[j] - mean; s2 += (v[j].x * v[j].x + v[j].y * v[j].y) + (v[j].z * v[j].z + v[j].w * v[j].w); }
    const float rstd = 1.f / sqrtf(wave_sum(s2) * (1.f / D) + LN_EPS);
#pragma unroll
    for (int j = 0; j < 4; ++j) { const f32x4 gg = ((const f32x4*)g)[lane + 64 * j], bb = ((const f32x4*)b)[lane + 64 * j]; v[j] = v[j] * rstd * gg + bb; }
}
__device__ __forceinline__ void store_bf16_row16(bf16* orow, const f32x4 (&v)[4], int lane) {
#pragma unroll
    for (int j = 0; j < 4; ++j) { u32x2 o; o.x = pk2(v[j].x, v[j].y); o.y = pk2(v[j].z, v[j].w); ((u32x2*)orow)[lane + 64 * j] = o; }
}
__device__ __forceinline__ void load_bf16_row16(const bf16* row, f32x4 (&v)[4], int lane) {
#pragma unroll
    for (int j = 0; j < 4; ++j) { const u32x2 u = ((const u32x2*)row)[lane + 64 * j]; v[j] = (f32x4){bf_lo(u.x), bf_hi(u.x), bf_lo(u.y), bf_hi(u.y)}; }
}
__device__ __forceinline__ void unpack8(const v4u u, float (&f)[8]) {
    f[0] = bf_lo(u.x); f[1] = bf_hi(u.x); f[2] = bf_lo(u.y); f[3] = bf_hi(u.y); f[4] = bf_lo(u.z); f[5] = bf_hi(u.z); f[6] = bf_lo(u.w); f[7] = bf_hi(u.w);
}
__device__ __forceinline__ v4u pack8(const float (&f)[8]) { v4u o; o.x = pk2(f[0], f[1]); o.y = pk2(f[2], f[3]); o.z = pk2(f[4], f[5]); o.w = pk2(f[6], f[7]); return o; }


__device__ __forceinline__ int f2key(float f) { const int b = __float_as_int(f); return b ^ ((b >> 31) & 0x7fffffff); }
__device__ __forceinline__ float key2f(int k) { return __int_as_float(k ^ ((k >> 31) & 0x7fffffff)); }
#define CE_DESC(a, b) do { const int _mx = max((a), (b)), _mn = min((a), (b)); (a) = _mx; (b) = _mn; } while (0)
__device__ __forceinline__ void sort16_desc(int (&a)[16]) {
#pragma unroll
    for (int k = 2; k <= 16; k <<= 1)
#pragma unroll
        for (int j = k >> 1; j > 0; j >>= 1)
#pragma unroll
            for (int i = 0; i < 16; ++i) { const int l = i ^ j; if (l > i) { if ((i & k) == 0) CE_DESC(a[i], a[l]); else CE_DESC(a[l], a[i]); } }
}
__device__ __forceinline__ void merge16_desc(int (&a)[16], const int (&b)[16]) {
#pragma unroll
    for (int i = 0; i < 16; ++i) a[i] = max(a[i], b[15 - i]);
#pragma unroll
    for (int j = 8; j > 0; j >>= 1)
#pragma unroll
        for (int i = 0; i < 16; ++i) { const int l = i ^ j; if (l > i) CE_DESC(a[i], a[l]); }
}

typedef __bf16 bf16x2_t __attribute__((ext_vector_type(2)));
__device__ __forceinline__ float dot2bf(unsigned w, unsigned x, float acc) { return __builtin_amdgcn_fdot2_f32_bf16(__builtin_bit_cast(bf16x2_t, w), __builtin_bit_cast(bf16x2_t, x), acc, false); }
__device__ __forceinline__ void sort128_asc(unsigned& k0, unsigned& k1, int lane) {
#pragma unroll
    for (int k = 2; k <= 128; k <<= 1) {
#pragma unroll
        for (int j = k >> 1; j > 0; j >>= 1) {
            if (j == 64) { const unsigned a = min(k0, k1), b = max(k0, k1); k0 = a; k1 = b; }
            else {
                const bool asc = (k == 128) ? true : ((lane & k) == 0);
                const bool keep_min = (((lane & j) == 0) == asc);
                const unsigned p0 = (unsigned)__shfl_xor((int)k0, j), p1 = (unsigned)__shfl_xor((int)k1, j);
                k0 = keep_min ? min(k0, p0) : max(k0, p0); k1 = keep_min ? min(k1, p1) : max(k1, p1);
            }
        }
    }
}

typedef float f32x2v __attribute__((ext_vector_type(2)));
__device__ __forceinline__ float swapadd32(float a, float b) { auto r = __builtin_amdgcn_permlane32_swap(__float_as_uint(a), __float_as_uint(b), false, false); const unsigned r0 = r[0], r1 = r[1]; return __uint_as_float(r0) + __uint_as_float(r1); }
__device__ __forceinline__ float swapadd16(float a, float b) { auto r = __builtin_amdgcn_permlane16_swap(__float_as_uint(a), __float_as_uint(b), false, false); const unsigned r0 = r[0], r1 = r[1]; return __uint_as_float(r0) + __uint_as_float(r1); }
template <int CTRL> __device__ __forceinline__ float dpp_get(float v) { return __builtin_bit_cast(float, __builtin_amdgcn_update_dpp(0, __builtin_bit_cast(int, v), CTRL, 0xf, 0xf, true)); }
__device__ __forceinline__ float reduce8(const float (&d)[8], int lane) {
    const float e0 = swapadd32(d[0], d[4]), e1 = swapadd32(d[1], d[5]), e2 = swapadd32(d[2], d[6]), e3 = swapadd32(d[3], d[7]);
    const float f0 = swapadd16(e0, e2), f1 = swapadd16(e1, e3);
    const bool b3 = (lane & 8) != 0;
    const float keep = b3 ? f1 : f0, send = b3 ? f0 : f1;
    float g = keep + dpp_get<0x140>(send);
    g += dpp_get<0x141>(g);
    g += dpp_get<0x4e>(g);
    g += dpp_get<0xb1>(g);
    return g;
}
__device__ __forceinline__ float gelu_as(float v) {
    const float av = fabsf(v), t = __builtin_amdgcn_rcpf(av * 0.2316418882f + 1.0f);
    float q = t * 0.5307027145f + (-0.7265760135f); q = q * t + 0.7107068705f; q = q * t + (-0.142248368f); q = q * t + 0.127414796f; q = q * t;
    const float e = __builtin_amdgcn_exp2f((v * v) * (-0.72134752044f));
    const float m = v * (q * e);
    return v < 0.f ? m : v - m;
}
__device__ __forceinline__ void fp8x16_to_f32(const v4u w, float (&f)[16]) {
    const unsigned ww[4] = {w.x, w.y, w.z, w.w};
#pragma unroll
    for (int j = 0; j < 4; ++j) { const f32x2v lo = __builtin_amdgcn_cvt_pk_f32_fp8((int)ww[j], false), hi = __builtin_amdgcn_cvt_pk_f32_fp8((int)ww[j], true);
        f[4 * j] = lo.x; f[4 * j + 1] = lo.y; f[4 * j + 2] = hi.x; f[4 * j + 3] = hi.y; }
}

__device__ __forceinline__ void sort512_asc(unsigned (&v)[8], int lane) {
#pragma unroll
    for (int k = 2; k <= 512; k <<= 1) {
#pragma unroll
        for (int j = k >> 1; j > 0; j >>= 1) {
            if (j >= 64) {
                const int dr = j >> 6;
#pragma unroll
                for (int r = 0; r < 8; ++r) if ((r & dr) == 0) {
                    const bool asc = (k == 512) ? true : (((r << 6) & k) == 0);
                    const unsigned a = min(v[r], v[r | dr]), b = max(v[r], v[r | dr]);
                    v[r] = asc ? a : b; v[r | dr] = asc ? b : a; }
            } else {
                const bool lower = (lane & j) == 0;
#pragma unroll
                for (int r = 0; r < 8; ++r) {
                    const bool asc = (k == 512) ? true : ((k >= 64) ? (((r << 6) & k) == 0) : ((lane & k) == 0));
                    const unsigned pv = (unsigned)__shfl_xor((int)v[r], j);
                    v[r] = (lower == asc) ? min(v[r], pv) : max(v[r], pv); }
            }
        }
    }
}
__device__ __forceinline__ float reduce4(float d0, float d1, float d2, float d3) {
    const float e0 = swapadd32(d0, d2), e1 = swapadd32(d1, d3);
    float g = swapadd16(e0, e1);
    g += dpp_get<0x140>(g); g += dpp_get<0x141>(g); g += dpp_get<0x4e>(g); g += dpp_get<0xb1>(g);
    return g;
}
__device__ __forceinline__ float dot16_fp8_bf(const v4u w, const v4u ha, const v4u hb) {
    const unsigned ww[4] = {w.x, w.y, w.z, w.w}; const unsigned hh[8] = {ha.x, ha.y, ha.z, ha.w, hb.x, hb.y, hb.z, hb.w}; float s0 = 0.f, s1 = 0.f;
#pragma unroll
    for (int j = 0; j < 4; ++j) { const f32x2v lo = __builtin_amdgcn_cvt_pk_f32_fp8((int)ww[j], false), hi = __builtin_amdgcn_cvt_pk_f32_fp8((int)ww[j], true);
        const unsigned b0 = __builtin_amdgcn_perm(__float_as_uint(lo.y), __float_as_uint(lo.x), 0x07060302u), b1 = __builtin_amdgcn_perm(__float_as_uint(hi.y), __float_as_uint(hi.x), 0x07060302u);
        s0 = dot2bf(b0, hh[2 * j], s0); s1 = dot2bf(b1, hh[2 * j + 1], s1); }
    return s0 + s1;
}
__device__ __forceinline__ float dot16_fp8_bf2(const v4u w, const v4u ha, const v4u hb) {
    const unsigned ww[4] = {w.x, w.y, w.z, w.w}; const unsigned hh[8] = {ha.x, ha.y, ha.z, ha.w, hb.x, hb.y, hb.z, hb.w}; float s0 = 0.f, s1 = 0.f;
#pragma unroll
    for (int j = 0; j < 4; ++j) { const bf16x2_t lo = __builtin_amdgcn_cvt_scalef32_pk_bf16_fp8(ww[j], 1.0f, false), hi = __builtin_amdgcn_cvt_scalef32_pk_bf16_fp8(ww[j], 1.0f, true);
        s0 = __builtin_amdgcn_fdot2_f32_bf16(lo, __builtin_bit_cast(bf16x2_t, hh[2 * j]), s0, false); s1 = __builtin_amdgcn_fdot2_f32_bf16(hi, __builtin_bit_cast(bf16x2_t, hh[2 * j + 1]), s1, false); }
    return s0 + s1;
}
__device__ __forceinline__ float dot16_fp8(const v4u w, const float (&h)[16]) {
    const unsigned ww[4] = {w.x, w.y, w.z, w.w}; float s0 = 0.f, s1 = 0.f;
#pragma unroll
    for (int j = 0; j < 4; ++j) { const f32x2v lo = __builtin_amdgcn_cvt_pk_f32_fp8((int)ww[j], false), hi = __builtin_amdgcn_cvt_pk_f32_fp8((int)ww[j], true);
        s0 = __builtin_fmaf(lo.x, h[4 * j], s0); s1 = __builtin_fmaf(lo.y, h[4 * j + 1], s1); s0 = __builtin_fmaf(hi.x, h[4 * j + 2], s0); s1 = __builtin_fmaf(hi.y, h[4 * j + 3], s1); }
    return s0 + s1;
}

struct Args { const float* in[27]; float* out; unsigned char* ws; };

__global__ void __launch_bounds__(NWAVES * 64, 2) fwd_kernel(Args args) {
    extern __shared__ __attribute__((aligned(16))) unsigned char lds_raw[];
    LAS unsigned char* lds = (LAS unsigned char*)lds_raw;
    volatile LAS unsigned* MISC = (volatile LAS unsigned*)(lds + MISC_OFF);
    const int tid = threadIdx.x, lane = tid & 63, wave = __builtin_amdgcn_readfirstlane(tid >> 6);
    const int G = gridDim.x; const int bx = blockIdx.x; const int vcu = (G % 8 == 0) ? (bx % 8) * (G / 8) + bx / 8 : bx;
    const int gw = vcu * NWAVES + wave, NGW = G * NWAVES;
    const size_t gtid = (size_t)gw * 64 + lane, nthr = (size_t)NGW * 64;
    unsigned char* ws = args.ws;
    gu32* ctl = (gu32*)(ws + WS_CTL);
    for (int u = tid; u < (LDS_BYTES - LDSCTL_OFF) / 4; u += NWAVES * 64) ((LAS unsigned*)(lds + LDSCTL_OFF))[u] = 0u;
    __syncthreads();
    XcdBarrier bar = xcd_barrier_post((unsigned*)(ctl + CW_BAR), MISC + 8);
#define GRID_BAR() xcd_barrier(bar)

    const float* x = args.in[0]; const float* p_in = args.in[1];
    const float *ln0_g = args.in[2], *ln0_b = args.in[3], *w_in = args.in[4], *b_in = args.in[5], *conv_w = args.in[6], *conv_b = args.in[7], *gn_g = args.in[8], *gn_b = args.in[9];
    const float *sg_ln_g = args.in[10], *sg_ln_b = args.in[11], *sg_w = args.in[12], *sg_b = args.in[13], *w_o = args.in[14], *b_o = args.in[15], *ln1_g = args.in[16], *ln1_b = args.in[17];
    const float *peer_wq = args.in[18], *peer_keys = args.in[19], *peer_u = args.in[20], *peer_v = args.in[21], *ple_wp = args.in[22], *ple_wg = args.in[23], *ple_bg = args.in[24], *ln2_g = args.in[25], *ln2_b = args.in[26];
    bf16 *WIN = (bf16*)(ws + WS_WIN), *WO = (bf16*)(ws + WS_WO), *WQ = (bf16*)(ws + WS_WQ), *WG = (bf16*)(ws + WS_WG), *WP = (bf16*)(ws + WS_WP), *KEYS = (bf16*)(ws + WS_KEYS), *SGW = (bf16*)(ws + WS_SGW);
    float* BINP = (float*)(ws + WS_BINP);
    unsigned char *U8 = ws + WS_UT, *V8 = ws + WS_VT; float* SC = (float*)(ws + WS_SC);
    bf16 *XN = (bf16*)(ws + WS_XN), *H1 = (bf16*)(ws + WS_H1), *PB = (bf16*)(ws + WS_PB);
    bf16 *CB = (bf16*)(ws + WS_CB), *GU = (bf16*)(ws + WS_GU), *VN = (bf16*)(ws + WS_VN), *PP = (bf16*)(ws + WS_PP), *MIX = (bf16*)(ws + WS_MIX), *GP = (bf16*)(ws + WS_GP);
    bf16 *Z = (bf16*)(ws + WS_Z), *MIXO = (bf16*)(ws + WS_MIXO), *Q = (bf16*)(ws + WS_Q);
    unsigned* PK = (unsigned*)(ws + WS_IDX);

    {
        LAS float* scr = (LAS float*)(lds + RING_OFF + wave * 16384);
        constexpr int I_IN = (D / 64) * (DIN / 32), I_O = (D / 64) * (D / 32), I_Q = (D / 64) * (2048 / 32), I_G = I_O, I_P = (PLE / 64) * (D / 32);
        constexpr int NITEMS = I_IN + I_O + I_Q + I_G + I_P;
        for (int it = gw; it < NITEMS; it += NGW) {
            int r = it;
            if (r < I_IN) { p0_transpose_item<true>(w_in, D, DIN, WIN, scr, r, lane); continue; } r -= I_IN;
            if (r < I_O) { p0_transpose_item<false>(w_o, D, D, WO, scr, r, lane); continue; } r -= I_O;
            if (r < I_Q) { p0_transpose_item<false>(peer_wq, D, 2048, WQ, scr, r, lane); continue; } r -= I_Q;
            if (r < I_G) { p0_transpose_item<false>(ple_wg, D, D, WG, scr, r, lane); continue; } r -= I_G;
            p0_transpose_item<false>(ple_wp, PLE, D, WP, scr, r, lane);
        }
        for (size_t i = gtid; i < DIN; i += nthr) BINP[i] = b_in[win_src((int)i)];
        cvt_f32_bf16(peer_keys, KEYS, (size_t)PHEADS * 2 * NKEYS * 128 / 4, gtid, nthr);
        for (size_t i = gtid; i < (size_t)NHEAD * CHUNK * CHUNK / 4; i += nthr) {
            const f32x4 v = ((const f32x4*)sg_w)[i]; const int e = (int)(i * 4), t = (e >> 7) & 127, s = e & 127;
            u32x2 o; o.x = pk2(s <= t ? v.x : 0.f, s + 1 <= t ? v.y : 0.f); o.y = pk2(s + 2 <= t ? v.z : 0.f, s + 3 <= t ? v.w : 0.f); ((u32x2*)SGW)[i] = o; }
        for (int m = gw; m < M; m += NGW) {
            f32x4 v[4];
#pragma unroll
            for (int j = 0; j < 4; ++j) v[j] = ((const f32x4*)(x + (size_t)m * D))[lane + 64 * j];
            ln16(v, ln0_g, ln0_b, lane); store_bf16_row16(XN + (size_t)m * D, v, lane);
        }
    }
    GRID_BAR();
    {
        pg8::Gemm g{XN, WIN, M, DIN, D}; pg8::StaticOrder S; S.init(M, DIN, G, bx);
        pg8::EpiBf16<0> E{Z, DIN, BINP, 0, 0, 1.f};
        pg8::gemm_phase<pg8::EpiBf16<0>, pg8::StaticOrder, true, true>(lds + RING_OFF, g, S, E);
    }
    GRID_BAR();
    for (int m = gw; m < M; m += NGW) {
        const bf16* z = Z + (size_t)m * DIN;
        { const int c0 = 8 * lane, j = c0 >> 7, lc = c0 & 127; float a[8], gt[8];
          unpack8(*(const v4u*)(z + 256 * j + lc), a); unpack8(*(const v4u*)(z + 256 * j + 128 + lc), gt);
#pragma unroll
          for (int i = 0; i < 8; ++i) a[i] = a[i] * sigmoidf_(gt[i]);
          *(v4u*)(CB + (size_t)m * CONVW + c0) = pack8(a); }
        { const int h = lane >> 3, ch0 = 8 * (lane & 7), lcs = 128 * (ch0 >> 5) + 32 * (h & 3) + (ch0 & 31); float u[8], v[8];
          unpack8(*(const v4u*)(z + 256 * (4 + (h >> 2)) + lcs), u); unpack8(*(const v4u*)(z + 256 * (6 + (h >> 2)) + lcs), v);
          float s = 0.f;
#pragma unroll
          for (int i = 0; i < 8; ++i) { u[i] = gelu_as(u[i]); v[i] = gelu_as(v[i]); s += v[i]; }
          *(v4u*)(GU + (size_t)m * SGWD + h * 64 + ch0) = pack8(u);
          s += __shfl_xor(s, 1); s += __shfl_xor(s, 2); s += __shfl_xor(s, 4);
          const float mean = s * (1.f / 64.f); float q = 0.f;
#pragma unroll
          for (int i = 0; i < 8; ++i) { v[i] -= mean; q += v[i] * v[i]; }
          q += __shfl_xor(q, 1); q += __shfl_xor(q, 2); q += __shfl_xor(q, 4);
          const float rstd = 1.f / sqrtf(q * (1.f / 64.f) + LN_EPS);
#pragma unroll
          for (int i = 0; i < 8; ++i) v[i] = v[i] * rstd * sg_ln_g[h * 64 + ch0 + i] + sg_ln_b[h * 64 + ch0 + i];
          *(v4u*)(VN + (size_t)m * SGWD + h * 64 + ch0) = pack8(v); }
    }
    GRID_BAR();
    cvt_f32_bf16(p_in, PB, (size_t)M * PLE / 4, gtid, nthr);
    for (int g4 = gw; g4 < M / 4; g4 += NGW) {
        const int m0 = g4 * 4, t0 = m0 & (SEQ - 1), c0 = 8 * lane; float acc[4][8];
        { const f32x4 b0 = *(const f32x4*)(conv_b + c0), b1 = *(const f32x4*)(conv_b + c0 + 4);
#pragma unroll
          for (int k = 0; k < 4; ++k) { acc[k][0] = b0.x; acc[k][1] = b0.y; acc[k][2] = b0.z; acc[k][3] = b0.w; acc[k][4] = b1.x; acc[k][5] = b1.y; acc[k][6] = b1.z; acc[k][7] = b1.w; } }
#define CONV_ROW(R, KLO, KHI) do { const int r_ = (R); const bool ok_ = (t0 + r_) >= 0;     \
            float xv[8]; unpack8(*(const v4u*)(CB + (size_t)(ok_ ? m0 + r_ : m0) * CONVW + c0), xv); \
            _Pragma("unroll") for (int i = 0; i < 8; ++i) xv[i] = ok_ ? xv[i] : 0.f; \
            _Pragma("unroll") for (int k = (KLO); k <= (KHI); ++k) { const float* wp_ = conv_w + (r_ - k + (CKER - 1)) * CONVW + c0; const f32x4 w0 = *(const f32x4*)wp_, w1 = *(const f32x4*)(wp_ + 4); \
                acc[k][0] += w0.x * xv[0]; acc[k][1] += w0.y * xv[1]; acc[k][2] += w0.z * xv[2]; acc[k][3] += w0.w * xv[3]; \
                acc[k][4] += w1.x * xv[4]; acc[k][5] += w1.y * xv[5]; acc[k][6] += w1.z * xv[6]; acc[k][7] += w1.w * xv[7]; } } while (0)
        CONV_ROW(-30, 0, 0); CONV_ROW(-29, 0, 1); CONV_ROW(-28, 0, 2);
#pragma unroll 4
        for (int r = -27; r <= 0; ++r) CONV_ROW(r, 0, 3);
        CONV_ROW(1, 1, 3); CONV_ROW(2, 2, 3); CONV_ROW(3, 3, 3);
#undef CONV_ROW
        const f32x4 g0 = *(const f32x4*)(gn_g + c0), g1 = *(const f32x4*)(gn_g + c0 + 4), be0 = *(const f32x4*)(gn_b + c0), be1 = *(const f32x4*)(gn_b + c0 + 4);
        const float gg[8] = {g0.x, g0.y, g0.z, g0.w, g1.x, g1.y, g1.z, g1.w}, bb[8] = {be0.x, be0.y, be0.z, be0.w, be1.x, be1.y, be1.z, be1.w};
#pragma unroll
        for (int k = 0; k < 4; ++k) {
            float s = 0.f;
#pragma unroll
            for (int i = 0; i < 8; ++i) s += acc[k][i];
            s += __shfl_xor(s, 1); s += __shfl_xor(s, 2); s += __shfl_xor(s, 4);
            const float mean = s * (1.f / 64.f); float q = 0.f;
#pragma unroll
            for (int i = 0; i < 8; ++i) { acc[k][i] -= mean; q += acc[k][i] * acc[k][i]; }
            q += __shfl_xor(q, 1); q += __shfl_xor(q, 2); q += __shfl_xor(q, 4);
            const float rstd = 1.f / sqrtf(q * (1.f / 64.f) + LN_EPS);
#pragma unroll
            for (int i = 0; i < 8; ++i) { const float y = acc[k][i] * rstd * gg[i] + bb[i]; acc[k][i] = y * sigmoidf_(y); }
            *(v4u*)(MIX + (size_t)(m0 + k) * D + c0) = pack8(acc[k]);
        }
    }
    for (int ch = vcu; ch < M / CHUNK; ch += G) {
        const int h = wave, r31 = lane & 31, hh = lane >> 5;
        LAS unsigned char* T = lds + RING_OFF + wave * 16384;
#pragma unroll 4
        for (int i = 0; i < 16; ++i) { const int e = lane + 64 * i, s = e >> 3, dc = e & 7;
            const v4u v = *(const v4u*)(VN + (size_t)(ch * CHUNK + s) * SGWD + h * 64 + dc * 8);
            const unsigned w[4] = {v.x, v.y, v.z, v.w};
#pragma unroll
            for (int k = 0; k < 8; ++k) { const int d = dc * 8 + k; const unsigned short val = (unsigned short)((k & 1) ? (w[k >> 1] >> 16) : (w[k >> 1] & 0xffffu));
                *(LAS unsigned short*)(T + d * 256 + (((s >> 3) ^ (d & 15)) << 4) + (s & 7) * 2) = val; } }
        LDS_WAIT(); asm volatile("" ::: "memory");
        f32x16 acc[2][4];
#pragma unroll
        for (int a = 0; a < 2; ++a)
#pragma unroll
            for (int b = 0; b < 4; ++b)
#pragma unroll
                for (int r = 0; r < 16; ++r) acc[a][b][r] = 0.f;
#pragma unroll 2
        for (int step = 0; step < 8; ++step) {
            bf16x8 A[2], B[4];
#pragma unroll
            for (int dm = 0; dm < 2; ++dm) { const int d = 32 * dm + r31; A[dm] = *(const LAS bf16x8*)(T + d * 256 + (((2 * step + hh) ^ (d & 15)) << 4)); }
#pragma unroll
            for (int tn = 0; tn < 4; ++tn) B[tn] = *(const bf16x8*)(SGW + ((size_t)h * CHUNK + 32 * tn + r31) * CHUNK + 16 * step + 8 * hh);
#pragma unroll
            for (int dm = 0; dm < 2; ++dm)
#pragma unroll
                for (int tn = 0; tn < 4; ++tn) acc[dm][tn] = __builtin_amdgcn_mfma_f32_32x32x16_bf16(A[dm], B[tn], acc[dm][tn], 0, 0, 0);
        }
#pragma unroll
        for (int tn = 0; tn < 4; ++tn) { const int t = 32 * tn + r31; const size_t m = (size_t)ch * CHUNK + t; const float bias = sg_b[h * CHUNK + t];
#pragma unroll
            for (int dm = 0; dm < 2; ++dm)
#pragma unroll
                for (int rq = 0; rq < 4; ++rq) { const int d0 = 32 * dm + 8 * rq + 4 * hh;
                    const u32x2 gu = *(const u32x2*)(GU + m * SGWD + h * 64 + d0);
                    u32x2 o; o.x = pk2(bf_lo(gu.x) * (acc[dm][tn][4 * rq + 0] + bias), bf_hi(gu.x) * (acc[dm][tn][4 * rq + 1] + bias));
                    o.y = pk2(bf_lo(gu.y) * (acc[dm][tn][4 * rq + 2] + bias), bf_hi(gu.y) * (acc[dm][tn][4 * rq + 3] + bias));
                    *(u32x2*)(MIX + m * D + 512 + h * 64 + d0) = o; } }
        LDS_WAIT(); asm volatile("" ::: "memory");
    }
    GRID_BAR();
    {
        pg8::Gemm g{MIX, WO, M, D, D}; pg8::StaticOrder S; S.init(M, D, G, bx);
        pg8::EpiBf16<0> E{MIXO, D, b_o, 0, 0, 1.f};
        pg8::gemm_phase<pg8::EpiBf16<0>, pg8::StaticOrder, true, true>(lds + RING_OFF, g, S, E);
    }
    GRID_BAR();
    for (int m = gw; m < M; m += NGW) {
        f32x4 a[4], b[4]; load_bf16_row16(XN + (size_t)m * D, a, lane); load_bf16_row16(MIXO + (size_t)m * D, b, lane);
#pragma unroll
        for (int j = 0; j < 4; ++j) a[j] = a[j] * ALPHA + b[j];
        ln16(a, ln1_g, ln1_b, lane); store_bf16_row16(H1 + (size_t)m * D, a, lane);
    }
    GRID_BAR();
    {
        { pg8::Gemm g{H1, WQ, M, 2048, D}; pg8::StaticOrder S; S.init(M, 2048, G, bx); pg8::EpiBf16<0> E{Q, 2048, nullptr, 0, 0, 1.f};
          pg8::gemm_phase<pg8::EpiBf16<0>, pg8::StaticOrder, true, true>(lds + RING_OFF, g, S, E); }
        { pg8::Gemm g{H1, WG, M, D, D}; pg8::StaticOrder S; S.init(M, D, G, bx); pg8::EpiBf16<0> E{GP, D, ple_bg, 0, 0, 1.f};
          pg8::gemm_phase<pg8::EpiBf16<0>, pg8::StaticOrder, true, true>(lds + RING_OFF, g, S, E); }
        { pg8::Gemm g{PB, WP, M, D, PLE}; pg8::StaticOrder S; S.init(M, D, G, bx); pg8::EpiBf16<0> E{PP, D, nullptr, 0, 0, 1.f};
          pg8::gemm_phase<pg8::EpiBf16<0>, pg8::StaticOrder, true, true>(lds + RING_OFF, g, S, E); }
    }
    GRID_BAR();
    {
      const int h = bx & 7, bi = bx >> 3, nbh = G >> 3;
      LAS unsigned char* kl = lds + RING_OFF;
#pragma unroll
      for (int j = 0; j < 8; ++j) { const int cidx = tid + 512 * j, row = cidx >> 4, ch = cidx & 15;
          const v4u kvv = *(const v4u*)(KEYS + ((size_t)h * 2 * NKEYS + row) * 128 + ch * 8);
          *(LAS v4u*)(kl + row * 256 + ((ch ^ (row & 15)) << 4)) = kvv; }
      __syncthreads();
      for (int tg = bi * NWAVES + wave; tg < M / 32; tg += nbh * NWAVES) {
        const int r31 = lane & 31, hh = lane >> 5; const size_t tok = (size_t)tg * 32 + r31;
        bf16x8 qf[2][8];
#pragma unroll
        for (int half = 0; half < 2; ++half)
#pragma unroll
            for (int step = 0; step < 8; ++step) qf[half][step] = *(const bf16x8*)(Q + tok * 2048 + h * 256 + half * 128 + 16 * step + 8 * hh);
        int t12[2][16];
#pragma unroll
        for (int half = 0; half < 2; ++half) {
            f32x16 acc[4];
#pragma unroll
            for (int kb = 0; kb < 4; ++kb)
#pragma unroll
                for (int r = 0; r < 16; ++r) acc[kb][r] = 0.f;
#pragma unroll
            for (int step = 0; step < 8; ++step) {
#pragma unroll
                for (int kb = 0; kb < 4; ++kb) { const int row = half * NKEYS + 32 * kb + r31; const bf16x8 A = *(const LAS bf16x8*)(kl + row * 256 + (((2 * step + hh) ^ (row & 15)) << 4));
                    acc[kb] = __builtin_amdgcn_mfma_f32_32x32x16_bf16(A, qf[half][step], acc[kb], 0, 0, 0); }
            }
            int g[4][16];
#pragma unroll
            for (int kb = 0; kb < 4; ++kb) {
#pragma unroll
                for (int r = 0; r < 16; ++r) { const int key = 32 * kb + (r & 3) + 8 * (r >> 2) + 4 * hh; g[kb][r] = (f2key(acc[kb][r]) & ~127) | key; }
                sort16_desc(g[kb]); }
            merge16_desc(g[0], g[1]); merge16_desc(g[2], g[3]); merge16_desc(g[0], g[2]);
            int o[16];
#pragma unroll
            for (int i = 0; i < 16; ++i) o[i] = __shfl_xor(g[0][i], 32);
            merge16_desc(g[0], o);
#pragma unroll
            for (int i = 0; i < 16; ++i) t12[half][i] = g[0][i];
        }
        LAS unsigned char* tab = lds + RING_OFF + 65536 + wave * 4096 + lane * 36;
#pragma unroll
        for (int w = 0; w < 8; ++w) { const int hf = w >> 2, i0 = 4 * (w & 3);
            *(LAS unsigned*)(tab + 4 * w) = (unsigned)(t12[hf][i0] & 127) | ((unsigned)(t12[hf][i0 + 1] & 127) << 8) | ((unsigned)(t12[hf][i0 + 2] & 127) << 16) | ((unsigned)(t12[hf][i0 + 3] & 127) << 24); }
        float f1[16], f2[16];
#pragma unroll
        for (int i = 0; i < 16; ++i) { f1[i] = key2f(t12[0][i] & ~127); f2[i] = key2f(t12[1][i] & ~127); }
        int c[4][16];
#pragma unroll
        for (int gidx = 0; gidx < 4; ++gidx)
#pragma unroll
            for (int k = 0; k < 16; ++k) c[gidx][k] = (int)0x80000000;
#define CAND(gi, k, i, j) c[gi][k] = (f2key(f1[i] + f2[j]) & ~255) | ((i) * 16 + (j))
#pragma unroll
        for (int j = 0; j < 16; ++j) CAND(0, j, 0, j);
#pragma unroll
        for (int j = 0; j < 8; ++j) CAND(1, j, 1, j);
#pragma unroll
        for (int j = 0; j < 5; ++j) CAND(1, 8 + j, 2, j);
#pragma unroll
        for (int j = 0; j < 3; ++j) CAND(1, 13 + j, 4, j);
#pragma unroll
        for (int j = 0; j < 4; ++j) CAND(2, j, 3, j);
#pragma unroll
        for (int j = 0; j < 2; ++j) { CAND(2, 4 + j, 5, j); CAND(2, 6 + j, 6, j); CAND(2, 8 + j, 7, j); }
#pragma unroll
        for (int i = 8; i < 14; ++i) CAND(2, 10 + (i - 8), i, 0);
        CAND(3, 0, 14, 0); CAND(3, 1, 15, 0);
#undef CAND
        sort16_desc(c[1]); sort16_desc(c[2]); sort16_desc(c[3]);
        merge16_desc(c[0], c[1]); merge16_desc(c[0], c[2]); merge16_desc(c[0], c[3]);
        float sc[16]; int se[16];
        const float m0 = key2f(c[0][0] & ~255); float sum = 0.f;
#pragma unroll
        for (int it = 0; it < 16; ++it) { const int id = c[0][it] & 255; const int a = tab[id >> 4], b = tab[16 + (id & 15)];
            se[it] = a * NKEYS + b; sc[it] = __expf(key2f(c[0][it] & ~255) - m0); sum += sc[it]; }
        const float inv = 1.f / sum;
        if (hh == 0) {
            unsigned* ip = PK + tok * NSEL + h * TOPK;
#pragma unroll
            for (int it = 0; it < 16; it += 4) { v4u o;
                o.x = ((unsigned)se[it] << 16) | (unsigned)__builtin_bit_cast(unsigned short, (_Float16)(sc[it] * inv));
                o.y = ((unsigned)se[it + 1] << 16) | (unsigned)__builtin_bit_cast(unsigned short, (_Float16)(sc[it + 1] * inv));
                o.z = ((unsigned)se[it + 2] << 16) | (unsigned)__builtin_bit_cast(unsigned short, (_Float16)(sc[it + 2] * inv));
                o.w = ((unsigned)se[it + 3] << 16) | (unsigned)__builtin_bit_cast(unsigned short, (_Float16)(sc[it + 3] * inv));
                *(v4u*)(ip + it) = o; }
        }
    }
      {
        for (int r = gw; r < 2 * NEXP; r += NGW) {
            const bool isv = r >= NEXP; const int e = isv ? r - NEXP : r;
            const f32x4* srcp = (const f32x4*)((isv ? peer_v : peer_u) + (size_t)e * D + 16 * lane);
            f32x4 xv[4]; float mx = 0.f;
#pragma unroll
            for (int j = 0; j < 4; ++j) { xv[j] = srcp[j]; mx = fmaxf(fmaxf(mx, fmaxf(fabsf(xv[j].x), fabsf(xv[j].y))), fmaxf(fabsf(xv[j].z), fabsf(xv[j].w))); }
#pragma unroll
            for (int o = 1; o < 64; o <<= 1) mx = fmaxf(mx, __shfl_xor(mx, o));
            mx = fmaxf(mx, 1e-30f); const float sc = 416.f / mx;
            v4u o4; unsigned wds[4];
            if (isv) {
#pragma unroll
                for (int j = 0; j < 4; ++j) { int w = __builtin_amdgcn_cvt_pk_fp8_f32(xv[j].x * sc, xv[j].y * sc, 0, false); w = __builtin_amdgcn_cvt_pk_fp8_f32(xv[j].z * sc, xv[j].w * sc, w, true); wds[j] = (unsigned)w; }
            } else {
                const float si = 127.f / mx;
#pragma unroll
                for (int j = 0; j < 4; ++j) wds[j] = ((unsigned)__float2int_rn(xv[j].x * si) & 0xffu) | (((unsigned)__float2int_rn(xv[j].y * si) & 0xffu) << 8) | (((unsigned)__float2int_rn(xv[j].z * si) & 0xffu) << 16) | (((unsigned)__float2int_rn(xv[j].w * si) & 0xffu) << 24);
            }
            o4.x = wds[0]; o4.y = wds[1]; o4.z = wds[2]; o4.w = wds[3];
            *(v4u*)((isv ? V8 : U8) + (size_t)e * D + 16 * lane) = o4;
            if (lane == 0) SC[2 * e + (isv ? 1 : 0)] = isv ? mx * (1.f / 416.f) : mx * (1.f / 127.f);
        }
      }
    }
    GRID_BAR();
    u32x2* ST2 = (u32x2*)(ws + WS_Q);
    {
        constexpr int TPW = 4, NB = 8, NPAIR = TPW * NSEL, NBATCH = NPAIR / NB, NSET = 3;
        LAS unsigned char* hl = lds + RING_OFF + wave * 16384;
        LAS unsigned* strm = (LAS unsigned*)(hl + TPW * 2048);
        LAS float* hsl = (LAS float*)(hl + TPW * 1024);
        LAS unsigned* offw = strm + TPW * NSEL;
        for (int base = gw * TPW; base < M; base += NGW * TPW) {
            const int lane_outer_ = lane; const size_t grp = (size_t)(base / TPW);
            {
                int lane = lane_outer_; asm volatile("" : "+v"(lane));
                unsigned kv[8];
#pragma unroll
                for (int r = 0; r < 8; ++r) { const int t = r >> 1; const unsigned pk = PK[(size_t)(base + t) * NSEL + (r & 1) * 64 + lane]; const unsigned idx = pk >> 16;
                    kv[r] = ((idx >> 9) << 27) | ((unsigned)t << 25) | ((idx & 511u) << 16) | (pk & 0xffffu); }
                sort512_asc(kv, lane);
#pragma unroll
                for (int r = 0; r < 8; ++r) { strm[lane + 64 * r] = kv[r]; offw[lane + 64 * r] = (((kv[r] >> 27) << 9) | ((kv[r] >> 16) & 511u)) << 10; }
            }
            int lane = lane_outer_; asm volatile("" : "+v"(lane));
#pragma unroll
            for (int t = 0; t < TPW; ++t) { float hf_[16];
                unpack8(*(const v4u*)(H1 + (size_t)(base + t) * D + 16 * lane), *(float(*)[8])&hf_[0]); unpack8(*(const v4u*)(H1 + (size_t)(base + t) * D + 16 * lane + 8), *(float(*)[8])&hf_[8]);
                float mx_ = 0.f;
#pragma unroll
                for (int i = 0; i < 16; ++i) mx_ = fmaxf(mx_, fabsf(hf_[i]));
#pragma unroll
                for (int o = 1; o < 64; o <<= 1) mx_ = fmaxf(mx_, __shfl_xor(mx_, o));
                mx_ = fmaxf(mx_, 1e-30f); const float si_ = 127.f / mx_; v4u hq_; unsigned wq_[4];
#pragma unroll
                for (int j = 0; j < 4; ++j) wq_[j] = ((unsigned)__float2int_rn(hf_[4 * j] * si_) & 0xffu) | (((unsigned)__float2int_rn(hf_[4 * j + 1] * si_) & 0xffu) << 8) | (((unsigned)__float2int_rn(hf_[4 * j + 2] * si_) & 0xffu) << 16) | (((unsigned)__float2int_rn(hf_[4 * j + 3] * si_) & 0xffu) << 24);
                hq_.x = wq_[0]; hq_.y = wq_[1]; hq_.z = wq_[2]; hq_.w = wq_[3];
                *(LAS v4u*)(hl + t * 1024 + 16 * lane) = hq_; if (lane == 0) hsl[t] = mx_ * (1.f / 127.f); }
            v4u uu[NSET][NB]; unsigned keyl[NSET]; f32x2v scl[NSET]; const unsigned lane16 = 16u * (unsigned)lane;
#define PEER_ISSUE(S, B) do { const int il_ = min((B) * NB + (lane >> 3), NPAIR - 1); keyl[S] = strm[il_]; const unsigned ol_ = offw[il_]; \
        scl[S] = *(const f32x2v*)(SC + (ol_ >> 9)); \
        _Pragma("unroll") for (int q = 0; q < NB; ++q) { const unsigned oq_ = (unsigned)__builtin_amdgcn_readlane((int)ol_, 8 * q); \
            uu[S][q] = *(const v4u*)((const unsigned char*)(U8 + oq_) + lane16); } } while (0)
#define PEER_COMPUTE(S, B) do { float d_[NB]; \
        _Pragma("unroll") for (int q = 0; q < NB; ++q) { const unsigned tq_ = ((unsigned)__builtin_amdgcn_readlane((int)keyl[S], 8 * q) >> 25) & 3u; \
            const v4u hv_ = *(const LAS v4u*)(hl + tq_ * 1024 + 16 * lane); const v4u w_ = uu[S][q]; \
            int a_ = __builtin_amdgcn_sdot4((int)w_.x, (int)hv_.x, 0, false); a_ = __builtin_amdgcn_sdot4((int)w_.y, (int)hv_.y, a_, false); \
            a_ = __builtin_amdgcn_sdot4((int)w_.z, (int)hv_.z, a_, false); a_ = __builtin_amdgcn_sdot4((int)w_.w, (int)hv_.w, a_, false); d_[q] = (float)a_; } \
        const float rr_ = reduce8(d_, lane); \
        const float gl_ = (float)__builtin_bit_cast(_Float16, (unsigned short)(keyl[S] & 0xffffu)); \
        const float hs_ = hsl[(keyl[S] >> 25) & 3u]; \
        const float cfv_ = gl_ * scl[S].y * gelu_as(scl[S].x * hs_ * rr_); \
        if ((lane & 7) == 0 && ((B) * NB + (lane >> 3)) < NPAIR) { u32x2 o_; o_.x = ((((keyl[S] >> 27) << 9) | ((keyl[S] >> 16) & 511u)) << 10) | ((keyl[S] >> 25) & 3u); o_.y = __float_as_uint(cfv_); ST2[grp * NPAIR + (B) * NB + (lane >> 3)] = o_; } } while (0)
            PEER_ISSUE(0, 0); PEER_ISSUE(1, 1);
            for (int b = 0; b < NBATCH + 2; b += 3) {
                PEER_ISSUE(2, b + 2); PEER_COMPUTE(0, b);
                PEER_ISSUE(0, b + 3); PEER_COMPUTE(1, b + 1);
                PEER_ISSUE(1, b + 4); PEER_COMPUTE(2, b + 2);
            }
#undef PEER_ISSUE
#undef PEER_COMPUTE
            LDS_WAIT(); asm volatile("" ::: "memory");
        }
    }
    GRID_BAR();
    {
        constexpr int TPW = 4, NB = 8, NPAIR = TPW * NSEL, NBATCH = NPAIR / NB, NSET = 3;
        LAS u32x2* st = (LAS u32x2*)(lds + RING_OFF + wave * 16384);
        for (int base = gw * TPW; base < M; base += NGW * TPW) {
            const size_t grp = (size_t)(base / TPW);
#pragma unroll
            for (int i = 0; i < 4; ++i) { const v4u e2 = *(const v4u*)((const unsigned*)(ST2 + grp * NPAIR) + (i * 64 + lane) * 4); *(LAS v4u*)((LAS unsigned*)st + (i * 64 + lane) * 4) = e2; }
            f32x2v acc2[TPW][8];
#pragma unroll
            for (int t = 0; t < TPW; ++t)
#pragma unroll
                for (int i = 0; i < 8; ++i) acc2[t][i] = (f32x2v){0.f, 0.f};
            v4u vv[NSET][NB]; u32x2 ent[NSET]; const unsigned lane16 = 16u * (unsigned)lane;
#define PEER_ISSUE(S, B) do { const int iu_ = (B) * NB + (lane >> 3); ent[S] = st[min(iu_, NPAIR - 1)]; if (iu_ >= NPAIR) ent[S].y = 0u; \
        _Pragma("unroll") for (int q = 0; q < NB; ++q) { const unsigned oq_ = (unsigned)__builtin_amdgcn_readlane((int)ent[S].x, 8 * q) & ~1023u; \
            vv[S][q] = *(const v4u*)((const unsigned char*)(V8 + oq_) + lane16); } } while (0)
#define PK_FMA_SEL2() asm volatile( \
        "s_cmp_lt_u32 %[ta], 2\n\ts_cbranch_scc0 2f\n\ts_cmp_eq_u32 %[ta], 0\n\ts_cbranch_scc0 1f\n\t \
        v_pk_fma_f32 %[a00], %[cfa], %[va0], %[a00]\n\tv_pk_fma_f32 %[a01], %[cfa], %[va1], %[a01]\n\tv_pk_fma_f32 %[a02], %[cfa], %[va2], %[a02]\n\tv_pk_fma_f32 %[a03], %[cfa], %[va3], %[a03]\n\tv_pk_fma_f32 %[a04], %[cfa], %[va4], %[a04]\n\tv_pk_fma_f32 %[a05], %[cfa], %[va5], %[a05]\n\tv_pk_fma_f32 %[a06], %[cfa], %[va6], %[a06]\n\tv_pk_fma_f32 %[a07], %[cfa], %[va7], %[a07]\n\ts_cmp_eq_u32 %[tb], 0\n\ts_cbranch_scc0 4f\n\tv_pk_fma_f32 %[a00], %[cfb], %[vb0], %[a00]\n\tv_pk_fma_f32 %[a01], %[cfb], %[vb1], %[a01]\n\tv_pk_fma_f32 %[a02], %[cfb], %[vb2], %[a02]\n\tv_pk_fma_f32 %[a03], %[cfb], %[vb3], %[a03]\n\tv_pk_fma_f32 %[a04], %[cfb], %[vb4], %[a04]\n\tv_pk_fma_f32 %[a05], %[cfb], %[vb5], %[a05]\n\tv_pk_fma_f32 %[a06], %[cfb], %[vb6], %[a06]\n\tv_pk_fma_f32 %[a07], %[cfb], %[vb7], %[a07]\n\ts_branch 9f\n" \
        "1:\n\tv_pk_fma_f32 %[a10], %[cfa], %[va0], %[a10]\n\tv_pk_fma_f32 %[a11], %[cfa], %[va1], %[a11]\n\tv_pk_fma_f32 %[a12], %[cfa], %[va2], %[a12]\n\tv_pk_fma_f32 %[a13], %[cfa], %[va3], %[a13]\n\tv_pk_fma_f32 %[a14], %[cfa], %[va4], %[a14]\n\tv_pk_fma_f32 %[a15], %[cfa], %[va5], %[a15]\n\tv_pk_fma_f32 %[a16], %[cfa], %[va6], %[a16]\n\tv_pk_fma_f32 %[a17], %[cfa], %[va7], %[a17]\n\ts_cmp_eq_u32 %[tb], 1\n\ts_cbranch_scc0 4f\n\tv_pk_fma_f32 %[a10], %[cfb], %[vb0], %[a10]\n\tv_pk_fma_f32 %[a11], %[cfb], %[vb1], %[a11]\n\tv_pk_fma_f32 %[a12], %[cfb], %[vb2], %[a12]\n\tv_pk_fma_f32 %[a13], %[cfb], %[vb3], %[a13]\n\tv_pk_fma_f32 %[a14], %[cfb], %[vb4], %[a14]\n\tv_pk_fma_f32 %[a15], %[cfb], %[vb5], %[a15]\n\tv_pk_fma_f32 %[a16], %[cfb], %[vb6], %[a16]\n\tv_pk_fma_f32 %[a17], %[cfb], %[vb7], %[a17]\n\ts_branch 9f\n" \
        "2:\n\ts_cmp_eq_u32 %[ta], 2\n\ts_cbranch_scc0 3f\n\tv_pk_fma_f32 %[a20], %[cfa], %[va0], %[a20]\n\tv_pk_fma_f32 %[a21], %[cfa], %[va1], %[a21]\n\tv_pk_fma_f32 %[a22], %[cfa], %[va2], %[a22]\n\tv_pk_fma_f32 %[a23], %[cfa], %[va3], %[a23]\n\tv_pk_fma_f32 %[a24], %[cfa], %[va4], %[a24]\n\tv_pk_fma_f32 %[a25], %[cfa], %[va5], %[a25]\n\tv_pk_fma_f32 %[a26], %[cfa], %[va6], %[a26]\n\tv_pk_fma_f32 %[a27], %[cfa], %[va7], %[a27]\n\ts_cmp_eq_u32 %[tb], 2\n\ts_cbranch_scc0 4f\n\tv_pk_fma_f32 %[a20], %[cfb], %[vb0], %[a20]\n\tv_pk_fma_f32 %[a21], %[cfb], %[vb1], %[a21]\n\tv_pk_fma_f32 %[a22], %[cfb], %[vb2], %[a22]\n\tv_pk_fma_f32 %[a23], %[cfb], %[vb3], %[a23]\n\tv_pk_fma_f32 %[a24], %[cfb], %[vb4], %[a24]\n\tv_pk_fma_f32 %[a25], %[cfb], %[vb5], %[a25]\n\tv_pk_fma_f32 %[a26], %[cfb], %[vb6], %[a26]\n\tv_pk_fma_f32 %[a27], %[cfb], %[vb7], %[a27]\n\ts_branch 9f\n" \
        "3:\n\tv_pk_fma_f32 %[a30], %[cfa], %[va0], %[a30]\n\tv_pk_fma_f32 %[a31], %[cfa], %[va1], %[a31]\n\tv_pk_fma_f32 %[a32], %[cfa], %[va2], %[a32]\n\tv_pk_fma_f32 %[a33], %[cfa], %[va3], %[a33]\n\tv_pk_fma_f32 %[a34], %[cfa], %[va4], %[a34]\n\tv_pk_fma_f32 %[a35], %[cfa], %[va5], %[a35]\n\tv_pk_fma_f32 %[a36], %[cfa], %[va6], %[a36]\n\tv_pk_fma_f32 %[a37], %[cfa], %[va7], %[a37]\n\ts_cmp_eq_u32 %[tb], 3\n\ts_cbranch_scc0 4f\n\tv_pk_fma_f32 %[a30], %[cfb], %[vb0], %[a30]\n\tv_pk_fma_f32 %[a31], %[cfb], %[vb1], %[a31]\n\tv_pk_fma_f32 %[a32], %[cfb], %[vb2], %[a32]\n\tv_pk_fma_f32 %[a33], %[cfb], %[vb3], %[a33]\n\tv_pk_fma_f32 %[a34], %[cfb], %[vb4], %[a34]\n\tv_pk_fma_f32 %[a35], %[cfb], %[vb5], %[a35]\n\tv_pk_fma_f32 %[a36], %[cfb], %[vb6], %[a36]\n\tv_pk_fma_f32 %[a37], %[cfb], %[vb7], %[a37]\n\ts_branch 9f\n" \
        "4:\n\ts_cmp_lt_u32 %[tb], 2\n\ts_cbranch_scc0 6f\n\ts_cmp_eq_u32 %[tb], 0\n\ts_cbranch_scc0 5f\n\tv_pk_fma_f32 %[a00], %[cfb], %[vb0], %[a00]\n\tv_pk_fma_f32 %[a01], %[cfb], %[vb1], %[a01]\n\tv_pk_fma_f32 %[a02], %[cfb], %[vb2], %[a02]\n\tv_pk_fma_f32 %[a03], %[cfb], %[vb3], %[a03]\n\tv_pk_fma_f32 %[a04], %[cfb], %[vb4], %[a04]\n\tv_pk_fma_f32 %[a05], %[cfb], %[vb5], %[a05]\n\tv_pk_fma_f32 %[a06], %[cfb], %[vb6], %[a06]\n\tv_pk_fma_f32 %[a07], %[cfb], %[vb7], %[a07]\n\ts_branch 9f\n" \
        "5:\n\tv_pk_fma_f32 %[a10], %[cfb], %[vb0], %[a10]\n\tv_pk_fma_f32 %[a11], %[cfb], %[vb1], %[a11]\n\tv_pk_fma_f32 %[a12], %[cfb], %[vb2], %[a12]\n\tv_pk_fma_f32 %[a13], %[cfb], %[vb3], %[a13]\n\tv_pk_fma_f32 %[a14], %[cfb], %[vb4], %[a14]\n\tv_pk_fma_f32 %[a15], %[cfb], %[vb5], %[a15]\n\tv_pk_fma_f32 %[a16], %[cfb], %[vb6], %[a16]\n\tv_pk_fma_f32 %[a17], %[cfb], %[vb7], %[a17]\n\ts_branch 9f\n" \
        "6:\n\ts_cmp_eq_u32 %[tb], 2\n\ts_cbranch_scc0 7f\n\tv_pk_fma_f32 %[a20], %[cfb], %[vb0], %[a20]\n\tv_pk_fma_f32 %[a21], %[cfb], %[vb1], %[a21]\n\tv_pk_fma_f32 %[a22], %[cfb], %[vb2], %[a22]\n\tv_pk_fma_f32 %[a23], %[cfb], %[vb3], %[a23]\n\tv_pk_fma_f32 %[a24], %[cfb], %[vb4], %[a24]\n\tv_pk_fma_f32 %[a25], %[cfb], %[vb5], %[a25]\n\tv_pk_fma_f32 %[a26], %[cfb], %[vb6], %[a26]\n\tv_pk_fma_f32 %[a27], %[cfb], %[vb7], %[a27]\n\ts_branch 9f\n" \
        "7:\n\tv_pk_fma_f32 %[a30], %[cfb], %[vb0], %[a30]\n\tv_pk_fma_f32 %[a31], %[cfb], %[vb1], %[a31]\n\tv_pk_fma_f32 %[a32], %[cfb], %[vb2], %[a32]\n\tv_pk_fma_f32 %[a33], %[cfb], %[vb3], %[a33]\n\tv_pk_fma_f32 %[a34], %[cfb], %[vb4], %[a34]\n\tv_pk_fma_f32 %[a35], %[cfb], %[vb5], %[a35]\n\tv_pk_fma_f32 %[a36], %[cfb], %[vb6], %[a36]\n\tv_pk_fma_f32 %[a37], %[cfb], %[vb7], %[a37]\n\t\n9:\n" \
        : [a00] "+v"(acc2[0][0]), [a01] "+v"(acc2[0][1]), [a02] "+v"(acc2[0][2]), [a03] "+v"(acc2[0][3]), [a04] "+v"(acc2[0][4]), [a05] "+v"(acc2[0][5]), [a06] "+v"(acc2[0][6]), [a07] "+v"(acc2[0][7]), [a10] "+v"(acc2[1][0]), [a11] "+v"(acc2[1][1]), [a12] "+v"(acc2[1][2]), [a13] "+v"(acc2[1][3]), [a14] "+v"(acc2[1][4]), [a15] "+v"(acc2[1][5]), [a16] "+v"(acc2[1][6]), [a17] "+v"(acc2[1][7]), [a20] "+v"(acc2[2][0]), [a21] "+v"(acc2[2][1]), [a22] "+v"(acc2[2][2]), [a23] "+v"(acc2[2][3]), [a24] "+v"(acc2[2][4]), [a25] "+v"(acc2[2][5]), [a26] "+v"(acc2[2][6]), [a27] "+v"(acc2[2][7]), [a30] "+v"(acc2[3][0]), [a31] "+v"(acc2[3][1]), [a32] "+v"(acc2[3][2]), [a33] "+v"(acc2[3][3]), [a34] "+v"(acc2[3][4]), [a35] "+v"(acc2[3][5]), [a36] "+v"(acc2[3][6]), [a37] "+v"(acc2[3][7]) \
        : [va0] "v"(vfa_[0]), [va1] "v"(vfa_[1]), [va2] "v"(vfa_[2]), [va3] "v"(vfa_[3]), [va4] "v"(vfa_[4]), [va5] "v"(vfa_[5]), [va6] "v"(vfa_[6]), [va7] "v"(vfa_[7]), [vb0] "v"(vfb_[0]), [vb1] "v"(vfb_[1]), [vb2] "v"(vfb_[2]), [vb3] "v"(vfb_[3]), [vb4] "v"(vfb_[4]), [vb5] "v"(vfb_[5]), [vb6] "v"(vfb_[6]), [vb7] "v"(vfb_[7]), [cfa] "s"(cfa2_), [cfb] "s"(cfb2_), [ta] "s"(ta_), [tb] "s"(tb_) : "scc")
#define CVT8(W, VF) do { const unsigned ww_[4] = {(W).x, (W).y, (W).z, (W).w}; _Pragma("unroll") for (int j = 0; j < 4; ++j) { VF[2 * j] = __builtin_amdgcn_cvt_scalef32_pk_f32_fp8(ww_[j], 1.0f, false); VF[2 * j + 1] = __builtin_amdgcn_cvt_scalef32_pk_f32_fp8(ww_[j], 1.0f, true); } } while (0)
#define PEER_COMPUTE(S, B) do { \
        _Pragma("unroll") for (int q = 0; q < NB; q += 2) { \
            const unsigned ka_ = (unsigned)__builtin_amdgcn_readlane((int)ent[S].x, 8 * q), kb_ = (unsigned)__builtin_amdgcn_readlane((int)ent[S].x, 8 * q + 8); const unsigned ta_ = ka_ & 3u, tb_ = kb_ & 3u; \
            const unsigned ca_ = (unsigned)__builtin_amdgcn_readlane((int)ent[S].y, 8 * q), cb_ = (unsigned)__builtin_amdgcn_readlane((int)ent[S].y, 8 * q + 8); \
            const unsigned long long cfa2_ = ((unsigned long long)ca_ << 32) | ca_, cfb2_ = ((unsigned long long)cb_ << 32) | cb_; \
            f32x2v vfa_[8], vfb_[8]; CVT8(vv[S][q], vfa_); CVT8(vv[S][q + 1], vfb_); \
            PK_FMA_SEL2(); } } while (0)
            PEER_ISSUE(0, 0); PEER_ISSUE(1, 1);
            for (int b = 0; b < NBATCH + 2; b += 3) {
                PEER_ISSUE(2, b + 2); PEER_COMPUTE(0, b);
                PEER_ISSUE(0, b + 3); PEER_COMPUTE(1, b + 1);
                PEER_ISSUE(1, b + 4); PEER_COMPUTE(2, b + 2);
            }
#undef PEER_ISSUE
#undef PEER_COMPUTE
#undef PK_FMA_SEL2
#undef CVT8
#pragma unroll
            for (int t = 0; t < TPW; ++t) {
                const size_t m = (size_t)(base + t);
                float hv[16], gv[16], pv[16];
                unpack8(*(const v4u*)(H1 + m * D + 16 * lane), *(float(*)[8])&hv[0]); unpack8(*(const v4u*)(H1 + m * D + 16 * lane + 8), *(float(*)[8])&hv[8]);
                unpack8(*(const v4u*)(GP + m * D + 16 * lane), *(float(*)[8])&gv[0]); unpack8(*(const v4u*)(GP + m * D + 16 * lane + 8), *(float(*)[8])&gv[8]);
                unpack8(*(const v4u*)(PP + m * D + 16 * lane), *(float(*)[8])&pv[0]); unpack8(*(const v4u*)(PP + m * D + 16 * lane + 8), *(float(*)[8])&pv[8]);
                float y[16], s = 0.f;
#pragma unroll
                for (int i = 0; i < 16; ++i) { y[i] = hv[i] * ALPHA + ((i & 1) ? acc2[t][i >> 1].y : acc2[t][i >> 1].x) + sigmoidf_(gv[i]) * pv[i]; s += y[i]; }
                const float mean = wave_sum(s) * (1.f / D); float q2 = 0.f;
#pragma unroll
                for (int i = 0; i < 16; ++i) { y[i] -= mean; q2 += y[i] * y[i]; }
                const float rstd = 1.f / sqrtf(wave_sum(q2) * (1.f / D) + LN_EPS);
#pragma unroll
                for (int c = 0; c < 4; ++c) { const int col = 16 * lane + 4 * c;
                    const f32x4 gg = *(const f32x4*)(ln2_g + col), bb = *(const f32x4*)(ln2_b + col);
                    f32x4 o; o.x = y[4 * c] * rstd * gg.x + bb.x; o.y = y[4 * c + 1] * rstd * gg.y + bb.y; o.z = y[4 * c + 2] * rstd * gg.z + bb.z; o.w = y[4 * c + 3] * rstd * gg.w + bb.w;
                    *(f32x4*)(args.out + m * D + col) = o; }
            }
            LDS_WAIT(); asm volatile("" ::: "memory");
        }
    }

}

extern "C" void kernel_launch(void* const* d_in, const int* in_sizes, int n_in, void* d_out, int out_size, void* d_ws, size_t ws_size, hipStream_t stream) {
    static int grid = 0;
    if (grid == 0) {
        if (n_in != 27 || in_sizes[0] != M * D || out_size != M * D || ws_size < WS_END) { fprintf(stderr, "kernel_launch: unexpected shapes (n_in %d, in0 %d, out %d, ws %zu)\n", n_in, n_in > 0 ? in_sizes[0] : -1, out_size, ws_size); grid = -1; return; }
        int dev = 0, cus = 0, per_cu = 0;
        if (hipGetDevice(&dev) != hipSuccess || hipDeviceGetAttribute(&cus, hipDeviceAttributeMultiprocessorCount, dev) != hipSuccess) { grid = -1; return; }
        if (hipFuncSetAttribute((const void*)fwd_kernel, hipFuncAttributeMaxDynamicSharedMemorySize, LDS_BYTES) != hipSuccess) { fprintf(stderr, "kernel_launch: hipFuncSetAttribute failed\n"); grid = -1; return; }
        if (hipOccupancyMaxActiveBlocksPerMultiprocessor(&per_cu, (const void*)fwd_kernel, NWAVES * 64, LDS_BYTES) != hipSuccess || per_cu < 1) fprintf(stderr, "kernel_launch: occupancy query says %d\n", per_cu);
        (void)hipGetLastError();
        grid = cus;
    }
    if (grid < 0) return;
    if (hipMemsetAsync((char*)d_ws + WS_CTL, 0, CTL_ZERO_BYTES, stream) != hipSuccess) return;
    Args a{};
    for (int i = 0; i < 27; ++i) a.in[i] = (const float*)d_in[i];
    a.out = (float*)d_out; a.ws = (unsigned char*)d_ws;
    hipLaunchKernelGGL(fwd_kernel, dim3(grid), dim3(NWAVES * 64), LDS_BYTES, stream, a);
}
```
